# Optimizing an MI355X kernel written in HIP

```python
import math
import jax, jax.numpy as jnp
from jax import lax
import numpy as np

D_MODEL = 1024
BATCH = 16
SEQ = 2048
DEPTH = 2

CHUNK = 64
D_BRANCH = 512
N_BRANCH = 3
S5_GROUP = 16
S5_GROUPS = D_BRANCH // S5_GROUP
S5_STATE = 64
DT_MIN = 1e-3
DT_MAX = 1e-1
POOL_WINDOWS = (2, 4, 8, 16)
POOL_GROUPS = len(POOL_WINDOWS)
POOL_GROUP = D_BRANCH // POOL_GROUPS
SGU_BLOCK = 128
SGU_HEADS = 4
SGU_HEAD_DIM = D_BRANCH // SGU_HEADS
IN_WIDTHS = (D_BRANCH, D_BRANCH, D_BRANCH, D_BRANCH, D_BRANCH, D_BRANCH, D_BRANCH, N_BRANCH * D_MODEL)
D_IN = sum(IN_WIDTHS)
RMS_EPS = 1e-6
LN_EPS = 1e-5

kernel_name = "hybrid_s5_pool_sgu_gated_trunk"


def rmsnorm(x, g):
    xf = x.astype(jnp.float32)
    y = xf * lax.rsqrt(jnp.mean(xf * xf, axis=-1, keepdims=True) + RMS_EPS)
    return (y * g.astype(jnp.float32)).astype(x.dtype)


def s5_mixer(u, lam_re, lam_im, log_dt, b_re, b_im, c_re, c_im, d_skip, w_glu, b_glu):
    bsz, seq, _ = u.shape
    uf = u.astype(jnp.float32).reshape(bsz, seq, S5_GROUPS, S5_GROUP)
    dt = jnp.exp(log_dt.astype(jnp.float32))[:, None]
    lr = lam_re.astype(jnp.float32)
    li = lam_im.astype(jnp.float32)
    mag = jnp.exp(lr * dt)
    ab_re = mag * jnp.cos(li * dt)
    ab_im = mag * jnp.sin(li * dt)
    den = lr * lr + li * li
    nr = ab_re - 1.0
    ni = ab_im
    k_re = (nr * lr + ni * li) / den
    k_im = (ni * lr - nr * li) / den
    br = b_re.astype(jnp.float32)
    bi = b_im.astype(jnp.float32)
    bb_re = k_re[..., None] * br - k_im[..., None] * bi
    bb_im = k_re[..., None] * bi + k_im[..., None] * br
    bu_re = jnp.einsum('gpc,blgc->blgp', bb_re, uf)
    bu_im = jnp.einsum('gpc,blgc->blgp', bb_im, uf)
    a_re = jnp.broadcast_to(ab_re[None, None], (1, seq, S5_GROUPS, S5_STATE))
    a_im = jnp.broadcast_to(ab_im[None, None], (1, seq, S5_GROUPS, S5_STATE))

    def combine(e1, e2):
        a1r, a1i, b1r, b1i = e1
        a2r, a2i, b2r, b2i = e2
        return (a2r * a1r - a2i * a1i,
                a2r * a1i + a2i * a1r,
                a2r * b1r - a2i * b1i + b2r,
                a2r * b1i + a2i * b1r + b2i)

    _, _, h_re, h_im = lax.associative_scan(combine, (a_re, a_im, bu_re, bu_im), axis=1)
    y = (jnp.einsum('gcp,blgp->blgc', c_re.astype(jnp.float32), h_re)
         - jnp.einsum('gcp,blgp->blgc', c_im.astype(jnp.float32), h_im))
    y = y + d_skip.astype(jnp.float32).reshape(S5_GROUPS, S5_GROUP) * uf
    y = jax.nn.gelu(y.reshape(bsz, seq, D_BRANCH))
    y = y * jax.nn.sigmoid(y @ w_glu.astype(jnp.float32) + b_glu.astype(jnp.float32))
    return y.astype(u.dtype)


def pool_mixer(u, w_pool, pool_scale):
    bsz, seq, _ = u.shape
    uf = u.astype(jnp.float32).reshape(bsz, seq, POOL_GROUPS, POOL_GROUP)
    cs = jnp.cumsum(uf, axis=1)
    pos = jnp.arange(1, seq + 1, dtype=jnp.float32)
    outs = []
    for gi, w in enumerate(POOL_WINDOWS):
        c = cs[:, :, gi]
        c_prev = jnp.pad(c, ((0, 0), (w, 0), (0, 0)))[:, :seq]
        mean = (c - c_prev) / jnp.minimum(pos, float(w))[None, :, None]
        outs.append(mean - uf[:, :, gi])
    p = jnp.stack(outs, axis=2)
    y = jnp.einsum('blgc,gcd->blgd', p, w_pool.astype(jnp.float32)).reshape(bsz, seq, D_BRANCH)
    return (y * pool_scale.astype(jnp.float32)).astype(u.dtype)


def sgu_mixer(u, v, ln_g, ln_b, w_s, b_s):
    bsz, seq, _ = v.shape
    vf = v.astype(jnp.float32)
    mu = jnp.mean(vf, axis=-1, keepdims=True)
    var = jnp.mean(jnp.square(vf - mu), axis=-1, keepdims=True)
    vn = (vf - mu) * lax.rsqrt(var + LN_EPS) * ln_g.astype(jnp.float32) + ln_b.astype(jnp.float32)
    vn = vn.reshape(bsz, seq // SGU_BLOCK, SGU_BLOCK, SGU_HEADS, SGU_HEAD_DIM)
    t = jnp.arange(SGU_BLOCK)
    mask = (t[None, :] // CHUNK) <= (t[:, None] // CHUNK)
    ws = jnp.where(mask[None], w_s.astype(jnp.float32), 0.0)
    z = jnp.einsum('hts,bnshc->bnthc', ws, vn) + b_s.astype(jnp.float32).T[None, None, :, :, None]
    z = z.reshape(bsz, seq, D_BRANCH)
    return (u.astype(jnp.float32) * z).astype(u.dtype)


def setup_inputs(seed: int = 0) -> dict:
    key = jax.random.key(seed)
    ks = jax.random.split(key, 24)
    f32 = jnp.float32
    n = jnp.arange(S5_STATE, dtype=f32)
    x = jax.random.normal(ks[0], (BATCH, SEQ, D_MODEL), f32)
    norm_g = 1.0 + 0.02 * jax.random.normal(ks[1], (DEPTH, D_MODEL), f32)
    w_in = jax.random.normal(ks[2], (DEPTH, D_MODEL, D_IN), f32) * D_MODEL ** -0.5
    s5_lam_re = -0.5 + 0.01 * jax.random.normal(ks[3], (DEPTH, S5_GROUPS, S5_STATE), f32)
    s5_lam_im = math.pi * n + 0.01 * jax.random.normal(ks[4], (DEPTH, S5_GROUPS, S5_STATE), f32)
    s5_log_dt = jax.random.uniform(ks[5], (DEPTH, S5_GROUPS), f32, math.log(DT_MIN), math.log(DT_MAX))
    bscale = (2.0 * S5_GROUP) ** -0.5
    s5_b_re = jax.random.normal(ks[6], (DEPTH, S5_GROUPS, S5_STATE, S5_GROUP), f32) * bscale
    s5_b_im = jax.random.normal(ks[7], (DEPTH, S5_GROUPS, S5_STATE, S5_GROUP), f32) * bscale
    cscale = (2.0 * S5_STATE) ** -0.5
    s5_c_re = jax.random.normal(ks[8], (DEPTH, S5_GROUPS, S5_GROUP, S5_STATE), f32) * cscale
    s5_c_im = jax.random.normal(ks[9], (DEPTH, S5_GROUPS, S5_GROUP, S5_STATE), f32) * cscale
    s5_d = jax.random.normal(ks[10], (DEPTH, D_BRANCH), f32)
    s5_w_glu = jax.random.normal(ks[11], (DEPTH, D_BRANCH, D_BRANCH), f32) * D_BRANCH ** -0.5
    s5_b_glu = 0.02 * jax.random.normal(ks[12], (DEPTH, D_BRANCH), f32)
    pool_w = jax.random.normal(ks[13], (DEPTH, POOL_GROUPS, POOL_GROUP, POOL_GROUP), f32) * POOL_GROUP ** -0.5
    pool_scale = 1.0 + 0.02 * jax.random.normal(ks[14], (DEPTH, D_BRANCH), f32)
    sgu_ln_g = 1.0 + 0.02 * jax.random.normal(ks[15], (DEPTH, D_BRANCH), f32)
    sgu_ln_b = 0.02 * jax.random.normal(ks[16], (DEPTH, D_BRANCH), f32)
    sgu_w = jax.random.normal(ks[17], (DEPTH, SGU_HEADS, SGU_BLOCK, SGU_BLOCK), f32) * SGU_BLOCK ** -0.5
    sgu_b = 1.0 + 0.02 * jax.random.normal(ks[18], (DEPTH, SGU_HEADS, SGU_BLOCK), f32)
    w_branch = jax.random.normal(ks[19], (DEPTH, N_BRANCH, D_BRANCH, D_MODEL), f32) * D_BRANCH ** -0.5
    w_out = jax.random.normal(ks[20], (DEPTH, D_MODEL, D_MODEL), f32) * D_MODEL ** -0.5
    final_norm_g = 1.0 + 0.02 * jax.random.normal(ks[21], (D_MODEL,), f32)
    return {"x": x, "norm_g": norm_g, "w_in": w_in,
            "s5_lam_re": s5_lam_re, "s5_lam_im": s5_lam_im, "s5_log_dt": s5_log_dt,
            "s5_b_re": s5_b_re, "s5_b_im": s5_b_im, "s5_c_re": s5_c_re, "s5_c_im": s5_c_im,
            "s5_d": s5_d, "s5_w_glu": s5_w_glu, "s5_b_glu": s5_b_glu,
            "pool_w": pool_w, "pool_scale": pool_scale,
            "sgu_ln_g": sgu_ln_g, "sgu_ln_b": sgu_ln_b, "sgu_w": sgu_w, "sgu_b": sgu_b,
            "w_branch": w_branch, "w_out": w_out, "final_norm_g": final_norm_g}


def reference(x, norm_g, w_in, s5_lam_re, s5_lam_im, s5_log_dt, s5_b_re, s5_b_im, s5_c_re, s5_c_im,
              s5_d, s5_w_glu, s5_b_glu, pool_w, pool_scale, sgu_ln_g, sgu_ln_b, sgu_w, sgu_b,
              w_branch, w_out, final_norm_g):
    bsz, seq, _ = x.shape
    split_idx = [int(v) for v in np.cumsum(IN_WIDTHS)[:-1]]
    for l in range(DEPTH):
        h = rmsnorm(x, norm_g[l])
        z = h @ w_in[l]
        a_val, a_gate, b_val, b_gate, c_u, c_v, c_gate, gates = jnp.split(z, split_idx, axis=-1)
        ya = s5_mixer(a_val, s5_lam_re[l], s5_lam_im[l], s5_log_dt[l], s5_b_re[l], s5_b_im[l],
                      s5_c_re[l], s5_c_im[l], s5_d[l], s5_w_glu[l], s5_b_glu[l]) * jax.nn.silu(a_gate)
        yb = pool_mixer(b_val, pool_w[l], pool_scale[l]) * jax.nn.silu(b_gate)
        yc = sgu_mixer(c_u, c_v, sgu_ln_g[l], sgu_ln_b[l], sgu_w[l], sgu_b[l]) * jax.nn.silu(c_gate)
        ys = jnp.stack([ya, yb, yc], axis=2)
        proj = jnp.einsum('blkc,kcd->blkd', ys, w_branch[l])
        g = jax.nn.sigmoid(gates.reshape(bsz, seq, N_BRANCH, D_MODEL))
        merged = jnp.sum(g * proj, axis=2)
        x = x + merged @ w_out[l]
    return rmsnorm(x, final_norm_g)
```

```cpp
#include <hip/hip_runtime.h>
#include <hip/hip_cooperative_groups.h>
#include <cstdio>
#include <cstdint>
namespace cg = cooperative_groups;

#ifndef REPM
#define REPM 0
#endif
#ifndef MK_COOP
#define MK_COOP 1
#endif

namespace pg8 {
#define PG8_LAS __attribute__((address_space(3)))
typedef unsigned short bf16_t;
typedef short bf16x8 __attribute__((ext_vector_type(8)));
typedef float f32x4 __attribute__((ext_vector_type(4)));
typedef unsigned u32x4 __attribute__((ext_vector_type(4)));
typedef unsigned u32x2 __attribute__((ext_vector_type(2)));
constexpr int BM = 256, BK = 64, HALF = 128, HTB = HALF * BK * 2, STAGE_BYTES = 8 * HTB, NXCD = 8, WGM = 8;

__host__ __device__ __forceinline__ int lds_byte(int r, int c) { const int st = (r >> 4) * 2 + (c >> 5), rr = r & 15, cc = c & 31, ob = rr * 64 + cc * 2; return st * 1024 + (ob ^ (((ob >> 9) & 1) << 5)); }
__host__ __device__ __forceinline__ void stage_rc(int b, int& R, int& C) { const int st = b / 1024, sb = b % 1024, swz = sb ^ (((sb >> 9) & 1) << 5); R = (st >> 1) * 16 + swz / 64; C = (st & 1) * 32 + (swz % 64) / 2; }
__host__ __device__ __forceinline__ int perm32(int rho) { const int n = rho >> 4, i = rho & 15; return 8 * (i >> 2) + 4 * n + (i & 3); }

struct Unit { int pm, pn, bz; };
struct Gemm { const bf16_t* A; const bf16_t* Bt; int lda, ldb, K; long sA, sB; int shA, mskA; long sA2; };

struct Order {
    int nM, nN, nB, nwg, G, c, lim, uneven;
    __device__ void init(int nM_, int nN_, int nB_, int G_, int c_, int lim_ = 0x7fffffff) { nM = nM_; nN = nN_; nB = nB_; nwg = nM * nN * nB; G = G_; c = c_; lim = lim_; uneven = 0; }
    __device__ bool next(int i, Unit& u) const {
        long L = (long)i * G + c;
        if (uneven) { if (i < 5) L = (long)i * 256 + c; else if (c >= 128 && i < 7) L = 1280 + (c - 128) * 2 + (i - 5); else return false; }
        if (L >= nwg || i >= lim) return false;
        int wgid = (int)L;
        if (nB == 1) {
            { const int q = nwg / NXCD, r = nwg % NXCD, xcd = wgid % NXCD, off = wgid / NXCD; wgid = (xcd < r ? xcd * (q + 1) : r * (q + 1) + (xcd - r) * q) + off; }
            const int nig = WGM * nN, gid = wgid / nig, fm = gid * WGM, gsz = (nM - fm) < WGM ? (nM - fm) : WGM;
            u.pm = fm + ((wgid % nig) % gsz); u.pn = (wgid % nig) / gsz; u.bz = 0;
        } else {
            const int per = nM * nN; u.bz = wgid / per; const int r = wgid % per; u.pm = r / nN; u.pn = r % nN;
        }
        return true;
    }
};

__device__ __forceinline__ unsigned cvt_pk_bf16(float lo, float hi) { unsigned r; asm volatile("v_cvt_pk_bf16_f32 %0, %1, %2" : "=v"(r) : "v"(lo), "v"(hi)); return r; }
__device__ __forceinline__ float bflo(unsigned w) { return __uint_as_float(w << 16); }
__device__ __forceinline__ float bfhi(unsigned w) { return __uint_as_float(w & 0xffff0000u); }
__device__ __forceinline__ float sigm(float v) { return __builtin_amdgcn_rcpf(1.0f + __builtin_amdgcn_exp2f(-1.44269504f * v)); }
__device__ __forceinline__ float silu(float v) { return v * sigm(v); }
__device__ __forceinline__ float gelu_t(float v) { const float z = 1.5957691216f * (v + 0.044715f * v * v * v); return v * sigm(z); }
__device__ __forceinline__ u32x4 pack8(const f32x4 a, const f32x4 b) { u32x4 w; w.x = cvt_pk_bf16(a[0], a[1]); w.y = cvt_pk_bf16(a[2], a[3]); w.z = cvt_pk_bf16(b[0], b[1]); w.w = cvt_pk_bf16(b[2], b[3]); return w; }
__device__ __forceinline__ void unpack8(const u32x4 w, f32x4& a, f32x4& b) { a[0] = bflo(w.x); a[1] = bfhi(w.x); a[2] = bflo(w.y); a[3] = bfhi(w.y); b[0] = bflo(w.z); b[1] = bfhi(w.z); b[2] = bflo(w.w); b[3] = bfhi(w.w); }

#define PG8_GAS __attribute__((address_space(1)))
typedef f32x4 Acc[2][2][4][2];

struct EpiIn {
    static constexpr bool PERM = true, AFTER_DRAIN = false, MID = false;
    const float* ssq; bf16_t *avs, *ag, *bv, *bg, *cu, *cv, *cgt, *gt; int mode;
    __device__ __forceinline__ void mid(Acc&, const Unit&, int, int, int, int, int) const {}
    __device__ __forceinline__ void operator()(const Acc& acc, const Unit& u, int wr, int wc, int fr, int fq) const {
        asm volatile("" : "+v"(fr), "+v"(fq));
        const int row0 = u.pm * BM + wr * 64 + fr, colt = u.pn * BM;
        int act, ldo, cb; bf16_t* base; bool isav = false;
        if (mode == 1) { act = 2; base = gt; ldo = 3072; cb = colt; }
        else { const int s = colt >> 9; cb = colt & 511; ldo = 512; act = (s == 1 || s == 3 || s == 6) ? 1 : 0; isav = (s == 0);
               base = s == 1 ? ag : s == 2 ? bv : s == 3 ? bg : s == 4 ? cu : s == 5 ? cv : cgt; }
        float rsv[2][4];
#pragma unroll
        for (int ai = 0; ai < 2; ++ai)
#pragma unroll
            for (int m = 0; m < 4; ++m) rsv[ai][m] = ssq[row0 + ai * HALF + m * 16];
#pragma unroll
        for (int ai = 0; ai < 2; ++ai)
#pragma unroll
            for (int m = 0; m < 4; ++m) {
                const int row = row0 + ai * HALF + m * 16; const float rs = rsqrtf(rsv[ai][m] * (1.0f / 1024.0f) + 1e-6f);
#pragma unroll
                for (int bj = 0; bj < 2; ++bj) {
                    const int col = cb + bj * HALF + wc * 32 + 8 * fq;
                    f32x4 v0 = acc[ai][bj][m][0] * rs, v1 = acc[ai][bj][m][1] * rs;
                    if (act != 0) {
                        f32x4 e0 = v0 * -1.44269504f, e1 = v1 * -1.44269504f;
#pragma unroll
                        for (int j = 0; j < 4; ++j) { e0[j] = __builtin_amdgcn_exp2f(e0[j]); e1[j] = __builtin_amdgcn_exp2f(e1[j]); }
                        e0 = e0 + 1.0f; e1 = e1 + 1.0f;
#pragma unroll
                        for (int j = 0; j < 4; ++j) { e0[j] = __builtin_amdgcn_rcpf(e0[j]); e1[j] = __builtin_amdgcn_rcpf(e1[j]); }
                        if (act == 1) { v0 = v0 * e0; v1 = v1 * e1; } else { v0 = e0; v1 = e1; }
                    }
                    bf16_t* p = isav ? avs + ((size_t)((col >> 5) * 2048 + (row >> 4)) * 768 + ((col >> 4) & 1) * 384 + (row & 15) * 16 + (col & 15))
                                     : base + (size_t)row * ldo + col;
                    *(PG8_GAS u32x4*)p = pack8(v0, v1);
                }
            }
    }
};
struct EpiState {
    static constexpr bool PERM = false, AFTER_DRAIN = false, MID = false;
    float* loc;
    __device__ __forceinline__ void mid(Acc&, const Unit&, int, int, int, int, int) const {}
    __device__ __forceinline__ void operator()(const Acc& acc, const Unit& u, int wr, int wc, int fr, int fq) const {
        asm volatile("" : "+v"(fr), "+v"(fq));
        const int row0 = u.pm * BM + wr * 64 + fr, col0 = wc * 32 + 4 * fq;
#pragma unroll
        for (int ai = 0; ai < 2; ++ai)
#pragma unroll
            for (int m = 0; m < 4; ++m) { float* rp = loc + ((size_t)u.bz * 2048 + row0 + ai * HALF + m * 16) * 256 + col0;
#pragma unroll
                for (int bj = 0; bj < 2; ++bj)
#pragma unroll
                    for (int n = 0; n < 2; ++n) *(PG8_GAS f32x4*)(rp + bj * HALF + n * 16) = acc[ai][bj][m][n]; }
    }
};
struct EpiToep {
    static constexpr bool PERM = true, AFTER_DRAIN = false, MID = false;
    const bf16_t* avs; const float* dsk; bf16_t* yg;
    __device__ __forceinline__ void mid(Acc&, const Unit&, int, int, int, int, int) const {}
    __device__ __forceinline__ void operator()(const Acc& acc, const Unit& u, int wr, int wc, int fr, int fq) const {
        asm volatile("" : "+v"(fr), "+v"(fq));
        const int g = u.bz, row0 = u.pm * BM + wr * 64 + fr;
        const bf16_t* ub = avs + (size_t)(g >> 1) * 2048 * 768 + (g & 1) * 384;
        const int c0 = (8 * fq) & 15;
        const f32x4 d0 = *(const PG8_GAS f32x4*)(dsk + g * 16 + c0), d1 = *(const PG8_GAS f32x4*)(dsk + g * 16 + c0 + 4);
#pragma unroll
        for (int ai = 0; ai < 2; ++ai) {
            u32x4 uq[4][2];
#pragma unroll
            for (int m = 0; m < 4; ++m)
#pragma unroll
                for (int bj = 0; bj < 2; ++bj) uq[m][bj] = *(const PG8_GAS u32x4*)(ub + (size_t)(row0 + ai * HALF + m * 16) * 768 + bj * HALF + wc * 32 + 8 * fq);
#pragma unroll
            for (int m = 0; m < 4; ++m) { const int sc = row0 + ai * HALF + m * 16;
#pragma unroll
                for (int bj = 0; bj < 2; ++bj) { const int col = bj * HALF + wc * 32 + 8 * fq;
                    f32x4 u0, u1; unpack8(uq[m][bj], u0, u1);
                    f32x4 v0 = acc[ai][bj][m][0] + d0 * u0, v1 = acc[ai][bj][m][1] + d1 * u1;
#pragma unroll
                    for (int j = 0; j < 4; ++j) { v0[j] = gelu_t(v0[j]); v1[j] = gelu_t(v1[j]); }
                    *(PG8_GAS u32x4*)(yg + (size_t)(sc * 16 + (col >> 4)) * 512 + g * 16 + c0) = pack8(v0, v1); } }
        }
    }
};
struct EpiGlu {
    static constexpr bool PERM = true, AFTER_DRAIN = false, MID = false;
    const bf16_t *yg, *ag; const float* bias; bf16_t* ycat;
    __device__ __forceinline__ void mid(Acc&, const Unit&, int, int, int, int, int) const {}
    __device__ __forceinline__ void operator()(const Acc& acc, const Unit& u, int wr, int wc, int fr, int fq) const {
        asm volatile("" : "+v"(fr), "+v"(fq));
        const int row0 = u.pm * BM + wr * 64 + fr, col0 = u.pn * BM + wc * 32 + 8 * fq;
        f32x4 bq[2][2];
#pragma unroll
        for (int bj = 0; bj < 2; ++bj) { bq[bj][0] = *(const PG8_GAS f32x4*)(bias + col0 + bj * HALF); bq[bj][1] = *(const PG8_GAS f32x4*)(bias + col0 + bj * HALF + 4); }
#pragma unroll
        for (int ai = 0; ai < 2; ++ai) {
            u32x4 yq[4][2], gq[4][2];
#pragma unroll
            for (int m = 0; m < 4; ++m)
#pragma unroll
                for (int bj = 0; bj < 2; ++bj) { const size_t o = (size_t)(row0 + ai * HALF + m * 16) * 512 + col0 + bj * HALF; yq[m][bj] = *(const PG8_GAS u32x4*)(yg + o); gq[m][bj] = *(const PG8_GAS u32x4*)(ag + o); }
#pragma unroll
            for (int m = 0; m < 4; ++m) { const size_t row = row0 + ai * HALF + m * 16;
#pragma unroll
                for (int bj = 0; bj < 2; ++bj) { const int col = col0 + bj * HALF;
                    const f32x4 b0 = bq[bj][0], b1 = bq[bj][1];
                    f32x4 y0, y1, g0, g1; unpack8(yq[m][bj], y0, y1); unpack8(gq[m][bj], g0, g1);
                    f32x4 v0 = acc[ai][bj][m][0] + b0, v1 = acc[ai][bj][m][1] + b1;
#pragma unroll
                    for (int j = 0; j < 4; ++j) { v0[j] = y0[j] * sigm(v0[j]) * g0[j]; v1[j] = y1[j] * sigm(v1[j]) * g1[j]; }
                    *(PG8_GAS u32x4*)(ycat + row * 1536 + col) = pack8(v0, v1); } }
        }
    }
};
struct EpiPool {
    static constexpr bool PERM = true, AFTER_DRAIN = false, MID = false;
    const bf16_t* bg; const float* scale; bf16_t* ycat;
    __device__ __forceinline__ void mid(Acc&, const Unit&, int, int, int, int, int) const {}
    __device__ __forceinline__ void operator()(const Acc& acc, const Unit& u, int wr, int wc, int fr, int fq) const {
        asm volatile("" : "+v"(fr), "+v"(fq));
        const int row0 = u.pm * BM + wr * 64 + fr, col0 = u.bz * 256 + wc * 32 + 8 * fq;
#pragma unroll
        for (int ai = 0; ai < 2; ++ai)
#pragma unroll
            for (int m = 0; m < 4; ++m) { const size_t row = row0 + ai * HALF + m * 16;
#pragma unroll
                for (int bj = 0; bj < 2; ++bj) { const int col = col0 + bj * HALF;
                    const f32x4 s0 = *(const PG8_GAS f32x4*)(scale + col), s1 = *(const PG8_GAS f32x4*)(scale + col + 4);
                    f32x4 g0, g1; unpack8(*(const PG8_GAS u32x4*)(bg + row * 512 + col), g0, g1);
                    const f32x4 v0 = acc[ai][bj][m][0] * s0 * g0, v1 = acc[ai][bj][m][1] * s1 * g1;
                    *(PG8_GAS u32x4*)(ycat + row * 1536 + 512 + col) = pack8(v0, v1); } }
    }
};
struct EpiSgu {
    static constexpr bool PERM = false, AFTER_DRAIN = true, MID = false;
    const bf16_t *cu, *cgt; const float* sb; bf16_t* ycat;
    __device__ __forceinline__ void mid(Acc&, const Unit&, int, int, int, int, int) const {}
    __device__ __forceinline__ void operator()(const Acc& acc, const Unit& u, int wr, int wc, int fr, int fq) const {
        asm volatile("" : "+v"(fr), "+v"(fq));
#pragma unroll
        for (int ai = 0; ai < 2; ++ai)
#pragma unroll
            for (int m = 0; m < 4; ++m) { const int blk = u.pm * 2 + ai, c = wr * 64 + m * 16 + fr;
#pragma unroll
                for (int bj = 0; bj < 2; ++bj) { const int h = u.bz * 2 + bj, ch = h * 128 + c;
#pragma unroll
                    for (int n = 0; n < 2; ++n) { const int t0 = wc * 32 + 16 * n + 4 * fq; const f32x4 bs = *(const PG8_GAS f32x4*)(sb + h * 128 + t0);
#pragma unroll
                        for (int j = 0; j < 4; ++j) { const size_t tok = (size_t)blk * 128 + t0 + j;
                            const float uu = __uint_as_float((unsigned)cu[tok * 512 + ch] << 16), gg = __uint_as_float((unsigned)cgt[tok * 512 + ch] << 16);
                            const float v = uu * (acc[ai][bj][m][n][j] + bs[j]) * gg;
                            ycat[tok * 1536 + 1024 + ch] = (bf16_t)(cvt_pk_bf16(v, 0.f) & 0xffffu); } } } }
    }
    __device__ __forceinline__ void fused(const Acc& acc, const Unit& u, int wr, int wc, int fr, int fq, PG8_LAS unsigned char* lds, int tid) const {
        asm volatile("" : "+v"(fr), "+v"(fq), "+v"(tid));
        PG8_LAS float* T = (PG8_LAS float*)lds;
#pragma unroll
        for (int ai = 0; ai < 2; ++ai) {
#pragma unroll
            for (int m = 0; m < 4; ++m)
#pragma unroll
                for (int bj = 0; bj < 2; ++bj)
#pragma unroll
                    for (int n = 0; n < 2; ++n)
#pragma unroll
                        for (int j = 0; j < 4; ++j) T[(bj * 128 + wc * 32 + 16 * n + 4 * fq + j) * 132 + wr * 64 + m * 16 + fr] = acc[ai][bj][m][n][j];
            __syncthreads();
            const int blk = u.pm * 2 + ai;
#pragma unroll 2
            for (int it = 0; it < 8; ++it) { const int item = it * 512 + tid, tt = item >> 4, cc = (item & 15) * 8, t = tt & 127, h = u.bz * 2 + (tt >> 7);
                const size_t tok = (size_t)blk * 128 + t; const int ch = h * 128 + cc;
                const f32x4 z0 = *(const PG8_LAS f32x4*)(T + tt * 132 + cc), z1 = *(const PG8_LAS f32x4*)(T + tt * 132 + cc + 4);
                const float bs = sb[h * 128 + t];
                f32x4 u0, u1, g0, g1; unpack8(*(const PG8_GAS u32x4*)(cu + tok * 512 + ch), u0, u1); unpack8(*(const PG8_GAS u32x4*)(cgt + tok * 512 + ch), g0, g1);
                const f32x4 v0 = u0 * (z0 + bs) * g0, v1 = u1 * (z1 + bs) * g1;
                *(PG8_GAS u32x4*)(ycat + tok * 1536 + 1024 + ch) = pack8(v0, v1); }
            __syncthreads();
        }
    }
};
struct EpiBranch {
    static constexpr bool PERM = true, AFTER_DRAIN = false, MID = true;
    const bf16_t* gt; bf16_t* mg;
    __device__ __forceinline__ void mid(Acc& acc, const Unit& u, int kb, int wr, int wc, int fr, int fq) const {
        asm volatile("" : "+v"(fr), "+v"(fq));
        const int row0 = u.pm * BM + wr * 64 + fr, col0 = u.pn * BM + wc * 32 + 8 * fq;
#pragma unroll
        for (int ai = 0; ai < 2; ++ai)
#pragma unroll
            for (int m = 0; m < 4; ++m) { const bf16_t* rp = gt + (size_t)(row0 + ai * HALF + m * 16) * 3072 + kb * 1024 + col0;
#pragma unroll
                for (int bj = 0; bj < 2; ++bj) { f32x4 a0, a1, b0, b1; unpack8(*(const PG8_GAS u32x4*)(rp + bj * HALF), a0, a1); unpack8(*(const PG8_GAS u32x4*)(rp + 1024 + bj * HALF), b0, b1);
#pragma unroll
                    for (int j = 0; j < 4; ++j) { acc[ai][bj][m][0][j] *= a0[j] * __builtin_amdgcn_rcpf(b0[j]); acc[ai][bj][m][1][j] *= a1[j] * __builtin_amdgcn_rcpf(b1[j]); } } }
    }
    __device__ __forceinline__ void operator()(const Acc& acc, const Unit& u, int wr, int wc, int fr, int fq) const {
        asm volatile("" : "+v"(fr), "+v"(fq));
        const int row0 = u.pm * BM + wr * 64 + fr, col0 = u.pn * BM + wc * 32 + 8 * fq;
#pragma unroll
        for (int ai = 0; ai < 2; ++ai) {
            u32x4 gq[4][2];
#pragma unroll
            for (int m = 0; m < 4; ++m)
#pragma unroll
                for (int bj = 0; bj < 2; ++bj) gq[m][bj] = *(const PG8_GAS u32x4*)(gt + (size_t)(row0 + ai * HALF + m * 16) * 3072 + 2048 + col0 + bj * HALF);
#pragma unroll
            for (int m = 0; m < 4; ++m) { const size_t row = row0 + ai * HALF + m * 16;
#pragma unroll
                for (int bj = 0; bj < 2; ++bj) { f32x4 a0, a1; unpack8(gq[m][bj], a0, a1);
                    *(PG8_GAS u32x4*)(mg + row * 1024 + col0 + bj * HALF) = pack8(acc[ai][bj][m][0] * a0, acc[ai][bj][m][1] * a1); } }
        }
    }
};
struct EpiOut {
    static constexpr bool PERM = true, AFTER_DRAIN = false, MID = false;
    bf16_t* xb; float* ssq;
    __device__ __forceinline__ void mid(Acc&, const Unit&, int, int, int, int, int) const {}
    __device__ __forceinline__ void operator()(const Acc& acc, const Unit& u, int wr, int wc, int fr, int fq) const {
        asm volatile("" : "+v"(fr), "+v"(fq));
        const int row0 = u.pm * BM + wr * 64 + fr, col0 = u.pn * BM + wc * 32 + 8 * fq;
#pragma unroll
        for (int ai = 0; ai < 2; ++ai) {
            u32x4 q[4][2];
#pragma unroll
            for (int m = 0; m < 4; ++m)
#pragma unroll
                for (int bj = 0; bj < 2; ++bj) q[m][bj] = *(const PG8_GAS u32x4*)(xb + (size_t)(row0 + ai * HALF + m * 16) * 1024 + col0 + bj * HALF);
#pragma unroll
            for (int m = 0; m < 4; ++m) { const size_t row = row0 + ai * HALF + m * 16; float s = 0.f;
#pragma unroll
                for (int bj = 0; bj < 2; ++bj) { f32x4 x0, x1; unpack8(q[m][bj], x0, x1);
                    const f32x4 v0 = x0 + acc[ai][bj][m][0], v1 = x1 + acc[ai][bj][m][1];
                    *(PG8_GAS u32x4*)(xb + row * 1024 + col0 + bj * HALF) = pack8(v0, v1);
                    s += ((v0[0] * v0[0] + v0[1] * v0[1]) + (v0[2] * v0[2] + v0[3] * v0[3])) + ((v1[0] * v1[0] + v1[1] * v1[1]) + (v1[2] * v1[2] + v1[3] * v1[3])); }
                if (ssq) { s += __shfl_xor(s, 16); s += __shfl_xor(s, 32); if (fq == 0) unsafeAtomicAdd(ssq + row, s); } }
        }
    }
};

template <class Epi>
__device__ __forceinline__ void gemm_phase(PG8_LAS unsigned char* lds, const Gemm g, const Order& S, const Epi& E) {
    int tid = threadIdx.x; asm volatile("" : "+v"(tid));
    const int wid = __builtin_amdgcn_readfirstlane(tid >> 6), lane = tid & 63, wr = wid >> 2, wc = wid & 3, fr = lane & 15, fq = lane >> 4;
    const int nt = g.K / BK;
    unsigned voffA[2], voffB[2];
#pragma unroll
    for (int i = 0; i < 2; ++i) { int R, C; stage_rc(tid * 16 + i * 8192, R, C); const int Rb = Epi::PERM ? ((R & ~31) + perm32(R & 31)) : R;
        voffA[i] = (unsigned)(R * g.lda + C) * 2u; voffB[i] = (unsigned)(Rb * g.ldb + C) * 2u; }
    const size_t kstep = (size_t)(BK * 2);
    const size_t hstepA = (size_t)HALF * g.lda * 2, hstepB = (size_t)HALF * g.ldb * 2;
    const unsigned ldsw = (unsigned)wid * 1024u;
    const int aoff = lds_byte(wr * 64 + fr, fq * 8), boff = lds_byte(wc * 32 + fr, fq * 8);
#define PG8_SA(b, h) (((b) * 2 + (h)) * HTB)
#define PG8_SB(b, h) ((4 + (b) * 2 + (h)) * HTB)
#define PG8_STAGE(bufoff, gbase, voff) do { _Pragma("unroll") for (int _i = 0; _i < 2; ++_i) \
        __builtin_amdgcn_global_load_lds((const unsigned*)((const char*)(gbase) + (voff)[_i]), (PG8_LAS unsigned*)(lds + (bufoff) + ldsw + _i * 8192), 16, 0, 0); } while (0)
#define PG8_LDA(dst, b, h) do { _Pragma("unroll") for (int m = 0; m < 4; ++m) _Pragma("unroll") for (int k = 0; k < 2; ++k) dst[m][k] = *(const PG8_LAS bf16x8*)(lds + PG8_SA(b, h) + aoff + m * 2048 + k * 1024); } while (0)
#define PG8_LDB(dst, b, h) do { _Pragma("unroll") for (int n = 0; n < 2; ++n) _Pragma("unroll") for (int k = 0; k < 2; ++k) dst[n][k] = *(const PG8_LAS bf16x8*)(lds + PG8_SB(b, h) + boff + n * 2048 + k * 1024); } while (0)
#define PG8_MMA(ai, bj, At, Bt) do { __builtin_amdgcn_s_setprio(1); _Pragma("unroll") for (int m = 0; m < 4; ++m) _Pragma("unroll") for (int n = 0; n < 2; ++n) _Pragma("unroll") for (int k = 0; k < 2; ++k) \
        acc[ai][bj][m][n] = __builtin_amdgcn_mfma_f32_16x16x32_bf16(Bt[n][k], At[m][k], acc[ai][bj][m][n], 0, 0, 0); __builtin_amdgcn_s_setprio(0); } while (0)
#define PG8_WAIT_V(n) asm volatile("s_waitcnt vmcnt(" #n ")" ::: "memory")
#define PG8_WAIT_L(n) asm volatile("s_waitcnt lgkmcnt(" #n ")" ::: "memory")
#define PG8_BAR __builtin_amdgcn_s_barrier()
#define PG8_SCHED __builtin_amdgcn_sched_barrier(0)
#define PG8_UA(u) ((const char*)g.A + ((size_t)((u).bz >> g.shA) * g.sA + (size_t)((u).bz & g.mskA) * g.sA2 + (size_t)(u).pm * BM * g.lda) * 2)
#define PG8_UB(u) ((const char*)g.Bt + ((size_t)(u).bz * g.sB + (size_t)(u).pn * BM * g.ldb) * 2)
    Unit cur, nxt; int ui = 0;
    if (!S.next(0, cur)) return;
    Acc acc;
#pragma unroll
    for (int a = 0; a < 2; ++a)
#pragma unroll
        for (int b = 0; b < 2; ++b)
#pragma unroll
            for (int m = 0; m < 4; ++m)
#pragma unroll
                for (int n = 0; n < 2; ++n) acc[a][b][m][n] = (f32x4){0.f, 0.f, 0.f, 0.f};
    bf16x8 At[4][2], B0[2][2], B1[2][2];
    const char* cA = PG8_UA(cur); const char* cB = PG8_UB(cur);
    PG8_STAGE(PG8_SB(0, 0), cB, voffB); PG8_STAGE(PG8_SB(0, 1), cB + hstepB, voffB); PG8_STAGE(PG8_SA(0, 0), cA, voffA); PG8_STAGE(PG8_SA(0, 1), cA + hstepA, voffA);
    if (wr == 1) PG8_BAR;
    PG8_WAIT_V(2); PG8_BAR;
    PG8_STAGE(PG8_SB(1, 0), cB + kstep, voffB); PG8_STAGE(PG8_SA(1, 0), cA + kstep, voffA); PG8_STAGE(PG8_SB(1, 1), cB + hstepB + kstep, voffB);
    PG8_WAIT_V(6); PG8_BAR;
    for (;;) {
        const bool has_next = S.next(ui + 1, nxt);
        const char* nA = has_next ? PG8_UA(nxt) : cA; const char* nB = has_next ? PG8_UB(nxt) : cB;
#pragma unroll 1
        for (int t = 0; t < nt; t += 2) {
            const bool last = (t == nt - 2);
            const char* a1 = cA + (size_t)(t + 1) * kstep;
            const char* a2 = last ? nA : cA + (size_t)(t + 2) * kstep; const char* b2 = last ? nB : cB + (size_t)(t + 2) * kstep;
            const char* a3 = a2 + kstep; const char* b3 = b2 + kstep;
            PG8_LDB(B0, 0, 0); PG8_LDB(B1, 0, 1); PG8_SCHED; PG8_LDA(At, 0, 0); PG8_STAGE(PG8_SA(1, 1), a1 + hstepA, voffA);
            PG8_WAIT_V(8); PG8_WAIT_L(0); PG8_BAR; PG8_MMA(0, 0, At, B0); PG8_MMA(0, 1, At, B1); PG8_BAR; PG8_SCHED;
            PG8_LDA(At, 0, 1); PG8_STAGE(PG8_SB(0, 0), b2, voffB); PG8_STAGE(PG8_SB(0, 1), b2 + hstepB, voffB); PG8_STAGE(PG8_SA(0, 0), a2, voffA);
            PG8_WAIT_V(8); PG8_WAIT_L(0); PG8_BAR; PG8_MMA(1, 0, At, B0); PG8_MMA(1, 1, At, B1); PG8_BAR; PG8_SCHED;
            PG8_LDB(B0, 1, 0); PG8_LDB(B1, 1, 1); PG8_SCHED; PG8_LDA(At, 1, 0); PG8_STAGE(PG8_SA(0, 1), a2 + hstepA, voffA);
            PG8_WAIT_V(8); PG8_WAIT_L(0); PG8_BAR; PG8_MMA(0, 0, At, B0); PG8_MMA(0, 1, At, B1); PG8_BAR; PG8_SCHED;
            PG8_LDA(At, 1, 1); PG8_STAGE(PG8_SB(1, 0), b3, voffB); PG8_STAGE(PG8_SB(1, 1), b3 + hstepB, voffB); PG8_STAGE(PG8_SA(1, 0), a3, voffA);
            PG8_WAIT_V(8); PG8_WAIT_L(0); PG8_BAR; PG8_MMA(1, 0, At, B0); PG8_MMA(1, 1, At, B1); PG8_BAR; PG8_SCHED;
            if constexpr (Epi::MID) { if (((t + 2) & 7) == 0 && !last) { E.mid(acc, cur, ((t + 2) >> 3) - 1, wr, wc, fr, fq); PG8_SCHED; } }
        }
        if (wr == 0) PG8_BAR;
        if constexpr (Epi::AFTER_DRAIN) { if (has_next) E(acc, cur, wr, wc, fr, fq); } else E(acc, cur, wr, wc, fr, fq);
        if (!has_next) break;
#pragma unroll
        for (int a = 0; a < 2; ++a)
#pragma unroll
            for (int b = 0; b < 2; ++b)
#pragma unroll
                for (int m = 0; m < 4; ++m)
#pragma unroll
                    for (int n = 0; n < 2; ++n) acc[a][b][m][n] = (f32x4){0.f, 0.f, 0.f, 0.f};
        cur = nxt; cA = nA; cB = nB; ++ui;
        if (wr == 1) PG8_BAR;
    }
    PG8_WAIT_V(0);
    PG8_BAR;
    if constexpr (Epi::AFTER_DRAIN) E.fused(acc, cur, wr, wc, fr, fq, lds, tid);
#undef PG8_SA
#undef PG8_SB
#undef PG8_STAGE
#undef PG8_LDA
#undef PG8_LDB
#undef PG8_MMA
#undef PG8_WAIT_V
#undef PG8_WAIT_L
#undef PG8_BAR
#undef PG8_SCHED
#undef PG8_UA
#undef PG8_UB
}
}

typedef unsigned short bf16;
typedef unsigned v4u __attribute__((ext_vector_type(4)));
typedef float f32x4 __attribute__((ext_vector_type(4)));
#define LAS __attribute__((address_space(3)))
#define GAS __attribute__((address_space(1)))
constexpr int M = 32768, D = 1024, DIN = 6656, DBR = 512, SEQ = 2048;
constexpr int LDS_BYTES = 147456;
constexpr int NPH = 16;
constexpr size_t MiB = 1u << 20;
constexpr size_t WS_SSQ0 = 0, WS_SSQ1 = 128 * 1024, WS_BAR = 512 * 1024;
constexpr size_t WS_WIN = 1 * MiB, WS_WGLU = 27 * MiB, WS_WBT = 28 * MiB, WS_WOT = 34 * MiB, WS_PWT = 38 * MiB, WS_SWT = 38 * MiB + 512 * 1024, WS_WST = 39 * MiB, WS_TP = 51 * MiB;
constexpr size_t WS_XB = 64 * MiB, WS_YCAT = 128 * MiB, WS_AG = 224 * MiB, WS_MG = 224 * MiB, WS_BV = 256 * MiB, WS_YG = 256 * MiB, WS_AVS = 288 * MiB, WS_GT = 288 * MiB,
                 WS_LOC = 336 * MiB, WS_BG = 368 * MiB, WS_CU = 400 * MiB, WS_CV = 432 * MiB, WS_CG = 464 * MiB, WS_END = 496 * MiB;

__device__ __forceinline__ unsigned f2bf(float f) { unsigned u = __builtin_bit_cast(unsigned, f); return (u + 0x7fffu + ((u >> 16) & 1u)) >> 16; }
__device__ __forceinline__ unsigned pk2(float lo, float hi) { return f2bf(lo) | (f2bf(hi) << 16); }
__device__ __forceinline__ float wave_sum(float v) {
#pragma unroll
    for (int o = 1; o < 64; o <<= 1) v += __shfl_xor(v, o);
    return v;
}
__device__ __forceinline__ double exp_small(double x) {
    double r = 1.0;
#pragma unroll
    for (int i = 22; i >= 1; --i) r = 1.0 + r * x * (1.0 / (double)i);
    return r;
}
__device__ __forceinline__ void sincos_rev(double rev, double& s, double& c) {
    double f = rev - floor(rev + 0.5);
    const double th = f * 6.283185307179586476925;
    const double t2 = th * th; double ss = 1.0, cc = 1.0;
#pragma unroll
    for (int i = 14; i >= 1; --i) { ss = 1.0 - ss * t2 * (1.0 / (double)((2 * i) * (2 * i + 1))); cc = 1.0 - cc * t2 * (1.0 / (double)((2 * i - 1) * (2 * i))); }
    s = th * ss; c = cc;
}
__device__ __forceinline__ void apow(double lr, double li, double dt, int d, double& re, double& im) {
    const double mag = exp_small(lr * dt * (double)d); double s, c; sincos_rev(li * dt * (double)d * 0.15915494309189533577, s, c);
    re = mag * c; im = mag * s;
}

__device__ __forceinline__ void p0_transpose_item(const float* W, int N, bf16* WT, int ldt, int koff, const float* gk, float* scr, int item, int lane) {
    const int nblk = N / 32, kb = item / nblk, nb = item % nblk, k0 = 64 * kb, n0 = 32 * nb;
#pragma unroll
    for (int i = 0; i < 32; ++i) { const int kk = 2 * i + (lane >> 5); float v = W[(size_t)(k0 + kk) * N + n0 + (lane & 31)]; if (gk) v *= gk[k0 + kk]; scr[kk * 33 + (lane & 31)] = v; }
    asm volatile("s_waitcnt lgkmcnt(0)" ::: "memory");
    const int c = lane & 7;
#pragma unroll
    for (int j = 0; j < 4; ++j) { const int n = (lane >> 3) + 8 * j; const float* s = scr + (8 * c) * 33 + n;
        v4u o; o.x = pk2(s[0 * 33], s[1 * 33]); o.y = pk2(s[2 * 33], s[3 * 33]); o.z = pk2(s[4 * 33], s[5 * 33]); o.w = pk2(s[6 * 33], s[7 * 33]);
        *(GAS v4u*)(WT + (size_t)(n0 + n) * ldt + koff + k0 + 8 * c) = o; }
    asm volatile("s_waitcnt lgkmcnt(0)" ::: "memory");
}

struct Args { const float* in[22]; float* out; unsigned char* ws; int ph_lo, ph_hi, coop, pad; };
enum { I_X = 0, I_NG, I_WIN, I_LRE, I_LIM, I_LDT, I_BRE, I_BIM, I_CRE, I_CIM, I_SD, I_WGLU, I_BGLU, I_PW, I_PS, I_LNG, I_LNB, I_SW, I_SB, I_WB, I_WO, I_FG };

__device__ __forceinline__ void setup_x(const Args& a, int G) {
    const int tid = threadIdx.x, lane = tid & 63, wave = tid >> 6, bx = blockIdx.x;
    unsigned char* ws = a.ws;
    {
        const int gw = bx * 8 + wave, NGW = G * 8;
        float* ssq0 = (float*)(ws + WS_SSQ0); float* ssq1 = (float*)(ws + WS_SSQ1);
        bf16* xb = (bf16*)(ws + WS_XB);
        for (int m = gw; m < M; m += 4 * NGW) {
            f32x4 v[4][4]; float sq[4];
#pragma unroll
            for (int r = 0; r < 4; ++r) { const int mr = m + r * NGW; const f32x4* xr = (const f32x4*)(a.in[I_X] + (size_t)(mr < M ? mr : m) * D) + lane;
#pragma unroll
                for (int j = 0; j < 4; ++j) v[r][j] = xr[64 * j]; }
#pragma unroll
            for (int r = 0; r < 4; ++r) { float s = 0.f;
#pragma unroll
                for (int j = 0; j < 4; ++j) s += (v[r][j].x * v[r][j].x + v[r][j].y * v[r][j].y) + (v[r][j].z * v[r][j].z + v[r][j].w * v[r][j].w);
                sq[r] = wave_sum(s); }
#pragma unroll
            for (int r = 0; r < 4; ++r) { const int mr = m + r * NGW;
                if (mr < M) { unsigned long long* o8 = (unsigned long long*)(xb + (size_t)mr * D) + lane;
#pragma unroll
                    for (int j = 0; j < 4; ++j) o8[64 * j] = (unsigned long long)pk2(v[r][j].x, v[r][j].y) | ((unsigned long long)pk2(v[r][j].z, v[r][j].w) << 32);
                    if (lane == 0) { ssq0[mr] = sq[r]; ssq1[mr] = 0.f; } } }
        }
    }
}

__device__ __forceinline__ void phase_setup(const Args& a, unsigned char* lds, int G) {
    const int tid = threadIdx.x, lane = tid & 63, wave = tid >> 6, bx = blockIdx.x;
    unsigned char* ws = a.ws;
    for (int task = bx; task < 256; task += G) {
        const int part = task & 3, l = task >> 7, g = (task >> 2) & 31;
        float* Ere = (float*)lds;
        float* Eim = Ere + 64 * 17;
        float* Bre = Eim + 64 * 17;
        float* Bim = Bre + 64 * 16;
        float* Cre = Bim + 64 * 16;
        float* Cim = Cre + 16 * 65;
        float* Kt = Cim + 16 * 65;
        const double dt = exp_small(0.25 * (double)a.in[I_LDT][l * 32 + g]);
        const double dtt = (dt * dt) * (dt * dt);
        const float* lre = a.in[I_LRE] + (l * 32 + g) * 64; const float* lim = a.in[I_LIM] + (l * 32 + g) * 64;
        for (int idx = tid; idx < 64 * 17; idx += 512) { const int p = idx / 17, d = idx % 17; double re, im; apow((double)lre[p], (double)lim[p], dtt, d, re, im); Ere[idx] = (float)re; Eim[idx] = (float)im; }
        for (int idx = tid; idx < 64 * 16; idx += 512) { const int p = idx >> 4;
            const double lr = (double)lre[p], li = (double)lim[p]; double are, aim; apow(lr, li, dtt, 1, are, aim);
            const double nr = are - 1.0, ni = aim, den = lr * lr + li * li, kre = (nr * lr + ni * li) / den, kim = (ni * lr - nr * li) / den;
            const double br = (double)a.in[I_BRE][(size_t)(l * 32 + g) * 1024 + idx], bi = (double)a.in[I_BIM][(size_t)(l * 32 + g) * 1024 + idx];
            Bre[idx] = (float)(kre * br - kim * bi); Bim[idx] = (float)(kre * bi + kim * br); }
        for (int idx = tid; idx < 1024; idx += 512) { const int o = (idx >> 6) * 65 + (idx & 63); Cre[o] = a.in[I_CRE][(size_t)(l * 32 + g) * 1024 + idx]; Cim[o] = a.in[I_CIM][(size_t)(l * 32 + g) * 1024 + idx]; }
        __syncthreads();
        if (part < 2) {
            { const int ph = tid & 1, co = (tid >> 1) & 15, d = tid >> 5;
              float sacc[16];
#pragma unroll
              for (int q = 0; q < 16; ++q) sacc[q] = 0.f;
              for (int p = ph * 32; p < ph * 32 + 32; ++p) {
                  const float er = Ere[p * 17 + d], ei = Eim[p * 17 + d], cr = Cre[co * 65 + p], cim = Cim[co * 65 + p];
                  const float cer = cr * er - cim * ei, cei = cr * ei + cim * er;
                  const f32x4* br4 = (const f32x4*)(Bre + p * 16); const f32x4* bi4 = (const f32x4*)(Bim + p * 16);
#pragma unroll
                  for (int q = 0; q < 4; ++q) { const f32x4 br = br4[q], bi = bi4[q];
#pragma unroll
                      for (int e = 0; e < 4; ++e) sacc[q * 4 + e] += cer * br[e] - cei * bi[e]; } }
#pragma unroll
              for (int q = 0; q < 16; ++q) sacc[q] += __shfl_xor(sacc[q], 1);
              if (ph == 0) {
#pragma unroll
                  for (int q = 0; q < 4; ++q) *(f32x4*)(Kt + (d << 8) + (co << 4) + q * 4) = (f32x4){sacc[q * 4], sacc[q * 4 + 1], sacc[q * 4 + 2], sacc[q * 4 + 3]}; } }
            __syncthreads();
            bf16* tp = (bf16*)(ws + WS_TP) + (size_t)(l * 32 + g) * 256 * 384;
            for (int i = 0; i < 32; ++i) { const int row = part * 128 + 4 * i + (tid >> 7), t = row >> 4, co = row & 15;
#pragma unroll
                for (int j = 0; j < 3; ++j) { const int k = (tid & 127) + 128 * j; float v;
                    if (j < 2) { const int sx = k >> 4, ci = k & 15; v = (sx <= t) ? Kt[((t - sx) << 8) + (co << 4) + ci] : 0.f; }
                    else { const int jj = k - 256, p = jj & 63; const float er = Ere[p * 17 + t + 1], ei = Eim[p * 17 + t + 1], cr = Cre[co * 65 + p], ci_ = Cim[co * 65 + p];
                           v = (jj < 64) ? (cr * er - ci_ * ei) : -(cr * ei + ci_ * er); }
                    tp[(size_t)row * 384 + k] = (bf16)f2bf(v); } }
        } else {
            bf16* wst = (bf16*)(ws + WS_WST) + ((size_t)(l * 16 + (g >> 1)) * 256 + (g & 1) * 128) * 768;
            for (int i = 0; i < 16; ++i) { const int jrow = (part - 2) * 64 + 4 * i + (tid >> 7), p = jrow & 63;
#pragma unroll
                for (int j = 0; j < 6; ++j) { const int col = (tid & 127) + 128 * j, gl2 = j / 3, k = col - gl2 * 384; float v = 0.f;
                    if (gl2 == (g & 1) && k < 256) { const int sx = k >> 4, cx = k & 15; const float er = Ere[p * 17 + 15 - sx], ei = Eim[p * 17 + 15 - sx], br = Bre[p * 16 + cx], bi = Bim[p * 16 + cx];
                        v = (jrow < 64) ? (er * br - ei * bi) : (er * bi + ei * br); }
                    wst[(size_t)jrow * 768 + col] = (bf16)f2bf(v); } }
        }
        __syncthreads();
    }
    {
        constexpr int I_IN = 16 * 26, I_GL = 8 * 2, I_BR = 8 * 4, I_OU = 16 * 4, PER = I_IN + I_GL + 3 * I_BR + I_OU;
        for (int it = bx; it < 2 * PER; it += G) {
            const int l = it / PER; int r = it % PER;
            const float* W; int N; bf16* WT; int ldt, koff = 0; const float* gk = nullptr;
            if (r < I_IN) { if ((r % 26) == 4 || (r % 26) == 5) continue;
                W = a.in[I_WIN] + (size_t)l * D * DIN; N = DIN; WT = (bf16*)(ws + WS_WIN) + (size_t)l * DIN * D; ldt = D; gk = a.in[I_NG] + l * D; }
            else if ((r -= I_IN) < I_GL) { W = a.in[I_WGLU] + (size_t)l * 512 * 512; N = 512; WT = (bf16*)(ws + WS_WGLU) + (size_t)l * 512 * 512; ldt = 512; }
            else if ((r -= I_GL) < 3 * I_BR) { const int kb3 = r / I_BR; r %= I_BR; W = a.in[I_WB] + (size_t)(l * 3 + kb3) * 512 * 1024; N = 1024; WT = (bf16*)(ws + WS_WBT) + (size_t)l * 1024 * 1536; ldt = 1536; koff = kb3 * 512; }
            else { r -= 3 * I_BR; W = a.in[I_WO] + (size_t)l * 1024 * 1024; N = 1024; WT = (bf16*)(ws + WS_WOT) + (size_t)l * 1024 * 1024; ldt = 1024; }
            const int nblk = N / 256, k0 = 64 * (r / nblk), n0 = 256 * (r % nblk);
            float* scr = (float*)lds;
#pragma unroll
            for (int i = 0; i < 8; ++i) { const int kk = i * 8 + (tid >> 6), c4 = (tid & 63) * 4;
                f32x4 v = *(const f32x4*)(W + (size_t)(k0 + kk) * N + n0 + c4); if (gk) v = v * gk[k0 + kk];
                scr[kk * 257 + c4] = v[0]; scr[kk * 257 + c4 + 1] = v[1]; scr[kk * 257 + c4 + 2] = v[2]; scr[kk * 257 + c4 + 3] = v[3]; }
            __syncthreads();
            const int c8 = tid & 7;
#pragma unroll
            for (int i = 0; i < 4; ++i) { const int n = (tid >> 3) + 64 * i; const float* sp = scr + (8 * c8) * 257 + n;
                v4u o; o.x = pk2(sp[0 * 257], sp[1 * 257]); o.y = pk2(sp[2 * 257], sp[3 * 257]); o.z = pk2(sp[4 * 257], sp[5 * 257]); o.w = pk2(sp[6 * 257], sp[7 * 257]);
                *(GAS v4u*)(WT + (size_t)(n0 + n) * ldt + koff + k0 + 8 * c8) = o; }
            __syncthreads();
        }
    }
    __syncthreads();
    for (int task = bx; task < 128; task += G) {
        const int l = task >> 6, gi = (task >> 4) & 3, k0 = (task & 15) * 64;
        float* A = (float*)lds;
        float* Bp = A + 64 * 129;
        const float* win = a.in[I_WIN] + (size_t)l * D * DIN; const float* ng = a.in[I_NG] + l * D;
        for (int idx = tid; idx < 64 * 128; idx += 512) { const int kk = idx >> 7, cx = idx & 127; A[kk * 129 + cx] = win[(size_t)(k0 + kk) * DIN + 1024 + gi * 128 + cx] * ng[k0 + kk]; }
        for (int idx = tid; idx < 128 * 128; idx += 512) { const int dx = idx & 127; Bp[idx] = a.in[I_PW][(size_t)(l * 4 + gi) * 16384 + idx] * a.in[I_PS][l * 512 + gi * 128 + dx]; }
        __syncthreads();
        { const int dx = tid & 127, kq = tid >> 7; float o[16];
#pragma unroll
          for (int q = 0; q < 16; ++q) o[q] = 0.f;
          for (int cx = 0; cx < 128; ++cx) { const float bvv = Bp[cx * 128 + dx];
#pragma unroll
              for (int q = 0; q < 16; ++q) o[q] += A[(kq * 16 + q) * 129 + cx] * bvv; }
          v4u w0, w1; w0.x = pk2(o[0], o[1]); w0.y = pk2(o[2], o[3]); w0.z = pk2(o[4], o[5]); w0.w = pk2(o[6], o[7]); w1.x = pk2(o[8], o[9]); w1.y = pk2(o[10], o[11]); w1.z = pk2(o[12], o[13]); w1.w = pk2(o[14], o[15]);
          bf16* dst = (bf16*)(ws + WS_WIN) + (size_t)l * DIN * D + (size_t)(1024 + gi * 128 + dx) * D + k0 + kq * 16;
          *(v4u*)dst = w0; *(GAS v4u*)(dst + 8) = w1; }
        __syncthreads();
    }
    {
        const size_t gt = (size_t)bx * 512 + tid, GT = (size_t)G * 512;
        bf16* pwt = (bf16*)(ws + WS_PWT); bf16* swt = (bf16*)(ws + WS_SWT);
        for (size_t idx = gt; idx < 2 * 2 * 65536; idx += GT) {
            const int k = idx & 255, n = (idx >> 8) & 255, q = (idx >> 16) & 1, l = (int)(idx >> 17);
            const int gl = n >> 7, d = n & 127, gl2 = k >> 7, c = k & 127;
            const float pv = (gl == gl2) ? a.in[I_PW][((size_t)(l * 4 + 2 * q + gl) * 128 + c) * 128 + d] : 0.f;
            pwt[idx] = (bf16)f2bf(pv);
            const int t = d, s = c;
            const float sv = (gl == gl2 && (s >> 6) <= (t >> 6)) ? a.in[I_SW][((size_t)(l * 4 + 2 * q + gl) * 128 + t) * 128 + s] : 0.f;
            swt[idx] = (bf16)f2bf(sv);
        }
    }
}

__device__ __forceinline__ void unpk8(const v4u q, float* v) { v[0] = pg8::bflo(q.x); v[1] = pg8::bfhi(q.x); v[2] = pg8::bflo(q.y); v[3] = pg8::bfhi(q.y); v[4] = pg8::bflo(q.z); v[5] = pg8::bfhi(q.z); v[6] = pg8::bflo(q.w); v[7] = pg8::bfhi(q.w); }
template <int W>
__device__ __forceinline__ void pool_item(const bf16* bv, const bf16* bg, bf16* ycat, int m0, int c0) {
    const int lpos0 = m0 & (SEQ - 1);
    v4u r[W + 7];
#pragma unroll
    for (int i = 0; i < W + 7; ++i) { const int off = i - (W - 1); r[i] = (lpos0 + off >= 0) ? *(const GAS v4u*)(bv + (size_t)(m0 + off) * 512 + c0) : (v4u){0u, 0u, 0u, 0u}; }
    float s[8], v[8];
#pragma unroll
    for (int j = 0; j < 8; ++j) s[j] = 0.f;
#pragma unroll
    for (int i = 0; i < W - 1; ++i) { unpk8(r[i], v);
#pragma unroll
        for (int j = 0; j < 8; ++j) s[j] += v[j]; }
#pragma unroll
    for (int t = 0; t < 8; ++t) {
        float x0[8]; unpk8(r[W - 1 + t], x0);
#pragma unroll
        for (int j = 0; j < 8; ++j) s[j] += x0[j];
        const int n = (lpos0 + t + 1 < W) ? lpos0 + t + 1 : W; const float inv = 1.0f / (float)n; v4u o;
        float gq[8]; unpk8(*(const GAS v4u*)(bg + (size_t)(m0 + t) * 512 + c0), gq);
        o.x = pk2((s[0] * inv - x0[0]) * gq[0], (s[1] * inv - x0[1]) * gq[1]); o.y = pk2((s[2] * inv - x0[2]) * gq[2], (s[3] * inv - x0[3]) * gq[3]);
        o.z = pk2((s[4] * inv - x0[4]) * gq[4], (s[5] * inv - x0[5]) * gq[5]); o.w = pk2((s[6] * inv - x0[6]) * gq[6], (s[7] * inv - x0[7]) * gq[7]);
        *(GAS v4u*)(ycat + (size_t)(m0 + t) * 1536 + 512 + c0) = o;
        unpk8(r[t], v);
#pragma unroll
        for (int j = 0; j < 8; ++j) s[j] -= v[j];
    }
}
__device__ __forceinline__ void phase_pre(const Args& a, unsigned char* lds, int l, int vb, int VB) {
    const int tid = threadIdx.x, lane = tid & 63, wave = tid >> 6;
    unsigned char* ws = a.ws;
    bf16* ycat = (bf16*)(ws + WS_YCAT);
    {
        const bf16* cv = (const bf16*)(ws + WS_CV);
        const float* lng = a.in[I_LNG] + l * 512; const float* lnb = a.in[I_LNB] + l * 512;
        unsigned* T = (unsigned*)lds;
        for (int blk = vb; blk < 256; blk += VB) {
            float gg[8], bb[8];
#pragma unroll
            for (int j = 0; j < 8; ++j) { gg[j] = lng[lane * 8 + j]; bb[j] = lnb[lane * 8 + j]; }
            v4u wq[16];
#pragma unroll
            for (int i = 0; i < 16; ++i) wq[i] = *(const GAS v4u*)(cv + ((size_t)blk * 128 + wave * 16 + i) * 512 + lane * 8);
#pragma unroll
            for (int i = 0; i < 16; ++i) { const int s = wave * 16 + i;
                float v[8]; unpk8(wq[i], v);
                float sm = 0.f;
#pragma unroll
                for (int j = 0; j < 8; ++j) sm += v[j];
                const float mu = wave_sum(sm) * (1.0f / 512.0f); float sq = 0.f;
#pragma unroll
                for (int j = 0; j < 8; ++j) { v[j] -= mu; sq += v[j] * v[j]; }
                const float rstd = rsqrtf(wave_sum(sq) * (1.0f / 512.0f) + 1e-5f);
#pragma unroll
                for (int j = 0; j < 4; ++j) T[s * 257 + lane * 4 + j] = pk2(v[2 * j] * rstd * gg[2 * j] + bb[2 * j], v[2 * j + 1] * rstd * gg[2 * j + 1] + bb[2 * j + 1]);
            }
            __syncthreads();
            const bf16* Tb = (const bf16*)T;
#pragma unroll 4
            for (int it = 0; it < 16; ++it) { const int idx = it * 512 + tid, sch = idx & 15, c = (idx >> 4) & 127, h = idx >> 11;
                unsigned o[4];
#pragma unroll
                for (int j = 0; j < 4; ++j) { const unsigned lo = Tb[(sch * 8 + 2 * j) * 514 + h * 128 + c], hi = Tb[(sch * 8 + 2 * j + 1) * 514 + h * 128 + c]; o[j] = lo | (hi << 16); }
                v4u ov; ov.x = o[0]; ov.y = o[1]; ov.z = o[2]; ov.w = o[3];
                *(GAS v4u*)(ycat + ((size_t)blk * 128 + c) * 1536 + 1024 + h * 128 + sch * 8) = ov; }
            __syncthreads();
        }
    }
    {
        const bf16* bv = (const bf16*)(ws + WS_BV); const bf16* bg = (const bf16*)(ws + WS_BG);
        for (int task = vb * 8 + wave; task < 4096; task += VB * 8) {
            const int gi = task >> 10, tq = task & 1023, m0 = (tq * 4 + (lane >> 4)) * 8, c0 = gi * 128 + (lane & 15) * 8;
            if (gi == 0) pool_item<2>(bv, bg, ycat, m0, c0); else if (gi == 1) pool_item<4>(bv, bg, ycat, m0, c0); else if (gi == 2) pool_item<8>(bv, bg, ycat, m0, c0); else pool_item<16>(bv, bg, ycat, m0, c0);
        }
    }
}

__device__ __forceinline__ void prefix_rb(const Args& a, unsigned char* lds, int l, int rb) {
    int tid = threadIdx.x; asm volatile("" : "+v"(tid)); const int sg = tid >> 7, rl = tid & 127;
    float* tot = (float*)lds;
    {
        const int r = rb * 128 + rl, p = r & 63, b = (r >> 6) & 15, g = r >> 10, pair = g >> 1, gl = g & 1;
        const double dt0 = exp_small(0.25 * (double)a.in[I_LDT][l * 32 + g]); const double dt = (dt0 * dt0) * (dt0 * dt0);
        double are, aim; apow((double)a.in[I_LRE][(l * 32 + g) * 64 + p], (double)a.in[I_LIM][(l * 32 + g) * 64 + p], dt, 16, are, aim);
        const float ar = (float)are, ai = (float)aim;
        const float* loc = (const float*)(a.ws + WS_LOC) + ((size_t)pair * 2048 + b * 128 + sg * 32) * 256 + gl * 128 + p;
        bf16* av = (bf16*)(a.ws + WS_AVS) + ((size_t)pair * 2048 + b * 128 + sg * 32) * 768 + gl * 384 + 256 + p;
        float xr[32], xi[32];
#pragma unroll
        for (int k = 0; k < 32; ++k) { xr[k] = loc[(size_t)k * 256]; xi[k] = loc[(size_t)k * 256 + 64]; }
        float sr = 0.f, si = 0.f;
#pragma unroll
        for (int k = 0; k < 32; ++k) { const float tr = xr[k], ti = xi[k]; xr[k] = sr; xi[k] = si; const float nr = ar * sr - ai * si + tr, ni = ar * si + ai * sr + ti; sr = nr; si = ni; }
        tot[(sg * 128 + rl) * 2] = sr; tot[(sg * 128 + rl) * 2 + 1] = si;
        float Ar = ar, Ai = ai;
#pragma unroll
        for (int q = 0; q < 5; ++q) { const float nr = Ar * Ar - Ai * Ai, ni = 2.f * Ar * Ai; Ar = nr; Ai = ni; }
        __syncthreads();
        float cr = 0.f, ci = 0.f;
        for (int j = 0; j < sg; ++j) { const float tr = tot[(j * 128 + rl) * 2], ti = tot[(j * 128 + rl) * 2 + 1]; const float nr = Ar * cr - Ai * ci + tr, ni = Ar * ci + Ai * cr + ti; cr = nr; ci = ni; }
        float pr = 1.f, pi = 0.f;
#pragma unroll
        for (int k = 0; k < 32; ++k) { const float vr = xr[k] + pr * cr - pi * ci, vi = xi[k] + pr * ci + pi * cr;
            av[(size_t)k * 768] = (bf16)f2bf(vr); av[(size_t)k * 768 + 64] = (bf16)f2bf(vi);
            const float nr = pr * ar - pi * ai, ni = pr * ai + pi * ar; pr = nr; pi = ni; }
        __syncthreads();
    }
}

__device__ __forceinline__ void phase_final(const Args& a, int G) {
    const int lane = threadIdx.x & 63, wave = threadIdx.x >> 6, gw = blockIdx.x * 8 + wave, NGW = G * 8;
    const f32x4* gp = (const f32x4*)a.in[I_FG]; f32x4 gv[4];
#pragma unroll
    for (int j = 0; j < 4; ++j) gv[j] = gp[(lane * 8 + (j >> 1) * 512 + (j & 1) * 4) >> 2];
    const bf16* xbp = (const bf16*)(a.ws + WS_XB);
    for (int m = gw; m < M; m += NGW) {
        const GAS v4u* xr = (const GAS v4u*)(xbp + (size_t)m * D) + lane; float v[2][8]; float s = 0.f;
#pragma unroll
        for (int h = 0; h < 2; ++h) { unpk8(xr[64 * h], v[h]);
#pragma unroll
            for (int j = 0; j < 8; ++j) s += v[h][j] * v[h][j]; }
        const float rs = rsqrtf(wave_sum(s) * (1.0f / 1024.0f) + 1e-6f);
        GAS f32x4* xo = (GAS f32x4*)(a.out + (size_t)m * D);
#pragma unroll
        for (int h = 0; h < 2; ++h)
#pragma unroll
            for (int q = 0; q < 2; ++q) xo[(lane * 8 + h * 512 + q * 4) >> 2] = (f32x4){v[h][q * 4], v[h][q * 4 + 1], v[h][q * 4 + 2], v[h][q * 4 + 3]} * rs * gv[h * 2 + q];
    }
}

#define XB_TMO      128
#define XB_XCNT(j)  (256  + 64 * (j))
#define XB_XSUB(j)  (1280 + 64 * (j))
#define XB_XGEN(j)  (2304 + 64 * (j))
#define XB_TOP      3328
#define XB_TOPGEN   3392
#define XCD_BAR_WORDS 3456
#define XB_SPIN_CAP (1u << 18)
__device__ __forceinline__ unsigned xb_ld(unsigned* p)              { return __hip_atomic_load(p, __ATOMIC_RELAXED, __HIP_MEMORY_SCOPE_AGENT); }
__device__ __forceinline__ unsigned xb_add(unsigned* p, unsigned v) { return __hip_atomic_fetch_add(p, v, __ATOMIC_RELAXED, __HIP_MEMORY_SCOPE_AGENT); }
__device__ __forceinline__ unsigned xb_xcc_id() { return (unsigned)__builtin_amdgcn_s_getreg((3 << 11) | 20) & 0xFu; }
#define XB_SPIN(cond, bar) do { unsigned _sp = 0; while (cond) { __builtin_amdgcn_s_sleep(1); \
    if ((++_sp & 255u) == 0u) { if (xb_ld(&(bar)[XB_TMO])) break; if (_sp > XB_SPIN_CAP) { atomicAdd(&(bar)[XB_TMO], 1u); break; } } } } while (0)
struct XcdBarrier { unsigned* bar; unsigned x; volatile LAS unsigned* st; };
__device__ __forceinline__ void xcd_barrier_complete(unsigned* bar, unsigned x, unsigned& nloc, unsigned& nx) {
    const unsigned G = gridDim.x * gridDim.y * gridDim.z;
    unsigned sum, cnt, mine, sp = 0u;
    for (;;) {
        sum = 0u; cnt = 0u; mine = 0u;
#pragma unroll
        for (unsigned j = 0; j < 16; ++j) { const unsigned c = xb_ld(&bar[XB_XCNT(j)]); sum += c; cnt += (c > 0u) ? 1u : 0u; mine = (j == x) ? c : mine; }
        if (sum == G) break;
        __builtin_amdgcn_s_sleep(1);
        if ((++sp & 255u) == 0u) { if (xb_ld(&bar[XB_TMO])) break; if (sp > XB_SPIN_CAP) { atomicAdd(&bar[XB_TMO], 1u); break; } }
    }
    nloc = mine > 0u ? mine : 1u; nx = cnt > 0u ? cnt : 1u;
}
__device__ __forceinline__ void xcd_barrier(const XcdBarrier& b) {
    asm volatile("s_waitcnt vmcnt(0)" ::: "memory");
    __syncthreads();
    if (threadIdx.x == 0) {
        unsigned* bar = b.bar;
        __builtin_amdgcn_s_waitcnt(0);
        unsigned nloc = b.st[0], nx = b.st[1];
        if (nloc == 0u) { xcd_barrier_complete(bar, b.x, nloc, nx); b.st[0] = nloc; b.st[1] = nx; }
        const unsigned old = xb_add(&bar[XB_XSUB(b.x)], 1u);
        const unsigned gen = old / nloc;
        if (old + 1u == (gen + 1u) * nloc) {
            __builtin_amdgcn_fence(__ATOMIC_RELEASE, "agent");
            asm volatile("s_waitcnt vmcnt(0)" ::: "memory");
            const unsigned og = xb_add(&bar[XB_TOP], 1u);
            const unsigned tg = og / nx;
            if (og + 1u == (tg + 1u) * nx) xb_add(&bar[XB_TOPGEN], 1u);
            else XB_SPIN(xb_ld(&bar[XB_TOPGEN]) == tg, bar);
            __builtin_amdgcn_fence(__ATOMIC_ACQUIRE, "agent");
            xb_add(&bar[XB_XGEN(b.x)], 1u);
            asm volatile("s_waitcnt vmcnt(0)" ::: "memory");
        } else {
            XB_SPIN(xb_ld(&bar[XB_XGEN(b.x)]) == gen, bar);
            __builtin_amdgcn_fence(__ATOMIC_ACQUIRE, "agent");
            asm volatile("s_waitcnt vmcnt(0)" ::: "memory");
        }
    }
    __syncthreads();
}

struct Ctx { const Args& a; unsigned char* lds; PG8_LAS unsigned char* ldsl; int G, bx; };
#define CTX_PTRS(l) unsigned char* ws = c.a.ws; asm volatile("" : "+s"(ws)); const Args& a = c.a; const int G = c.G, bx = c.bx; PG8_LAS unsigned char* ldsl = c.ldsl; \
    bf16* xb = (bf16*)(ws + WS_XB); bf16* ycat = (bf16*)(ws + WS_YCAT); bf16* avs = (bf16*)(ws + WS_AVS); bf16* gt = (bf16*)(ws + WS_GT); \
    const float* ssq = (const float*)(ws + ((l) == 0 ? WS_SSQ0 : WS_SSQ1)); const bf16* win = (const bf16*)(ws + WS_WIN) + (size_t)(l) * DIN * D; pg8::Order S; \
    (void)xb; (void)ycat; (void)avs; (void)gt; (void)ssq; (void)win; (void)a; (void)G; (void)bx; (void)ldsl;
__device__ __forceinline__ void run_pa(const Ctx& c, int l) { CTX_PTRS(l)
    pg8::Gemm g{xb, win, D, D, D, 0, 0, 0, 0, 0}; S.init(128, 14, 1, G, bx);
    pg8::EpiIn E{ssq, avs, (bf16*)(ws + WS_AG), (bf16*)(ws + WS_BV), (bf16*)(ws + WS_BG), (bf16*)(ws + WS_CU), (bf16*)(ws + WS_CV), (bf16*)(ws + WS_CG), gt, 0};
    pg8::gemm_phase<pg8::EpiIn>(ldsl, g, S, E); }
__device__ __forceinline__ void block_publish() { asm volatile("s_waitcnt vmcnt(0)" ::: "memory"); __syncthreads(); __builtin_amdgcn_fence(__ATOMIC_ACQUIRE, "agent"); asm volatile("s_waitcnt vmcnt(0)" ::: "memory"); }
__device__ __forceinline__ void pb_state_task(const Ctx& c, int l, int task) { CTX_PTRS(l)
    const int pair = task >> 3, pm = task & 7;
    { pg8::Gemm g{avs, (const bf16*)(ws + WS_WST) + (size_t)l * 16 * 256 * 768, 768, 768, 768, 2048L * 768, 256L * 768, 0, 0, 0}; S.init(8, 1, 16, 1 << 20, pair * 8 + pm, 1);
      pg8::EpiState E{(float*)(ws + WS_LOC)};
      pg8::gemm_phase<pg8::EpiState>(ldsl, g, S, E); }
    block_publish();
    prefix_rb(a, c.lds, l, (2 * pair) * 8 + pm); prefix_rb(a, c.lds, l, (2 * pair + 1) * 8 + pm);
}
__device__ __forceinline__ void run_pb(const Ctx& c, int l) {
    const int G = c.G, bx = c.bx, half = G / 2;
    if (G >= 2 && bx >= half) phase_pre(c.a, c.lds, l, bx - half, G - half);
    else {
        if (G < 2) phase_pre(c.a, c.lds, l, 0, 1);
        const int step = G >= 2 ? half : 1;
#pragma unroll 1
        for (int task = bx; task < 128; task += step) pb_state_task(c, l, task);
    } }
__device__ __forceinline__ void run_pc(const Ctx& c, int l) { CTX_PTRS(l)
    { pg8::Gemm g{ycat + 1024, (const bf16*)(ws + WS_SWT) + (size_t)l * 2 * 65536, 1536, 256, 256, 256, 65536, 0, 0, 0}; S.init(128, 1, 2, G, bx);
      pg8::EpiSgu E{(const bf16*)(ws + WS_CU), (const bf16*)(ws + WS_CG), a.in[I_SB] + l * 512, ycat};
      pg8::gemm_phase<pg8::EpiSgu>(ldsl, g, S, E); } }
__device__ __forceinline__ void run_pd(const Ctx& c, int l) { CTX_PTRS(l)
    pg8::Gemm g{avs, (const bf16*)(ws + WS_TP) + (size_t)l * 32 * 256 * 384, 768, 384, 384, 2048L * 768, 256L * 384, 1, 1, 384}; S.init(8, 1, 32, G, bx);
    pg8::EpiToep E{avs, a.in[I_SD] + l * 512, (bf16*)(ws + WS_YG)};
    pg8::gemm_phase<pg8::EpiToep>(ldsl, g, S, E); }
__device__ __forceinline__ void run_pe(const Ctx& c, int l) { CTX_PTRS(l)
    const bool split = (G == 256);
    if (!split || bx < 128) { pg8::Gemm g{(const bf16*)(ws + WS_YG), (const bf16*)(ws + WS_WGLU) + (size_t)l * 512 * 512, 512, 512, 512, 0, 0, 0, 0, 0};
      if (split) S.init(128, 2, 1, 128, bx, 2); else S.init(128, 2, 1, G, bx);
      pg8::EpiGlu E{(const bf16*)(ws + WS_YG), (const bf16*)(ws + WS_AG), a.in[I_BGLU] + l * 512, ycat};
      pg8::gemm_phase<pg8::EpiGlu>(ldsl, g, S, E); }
    { pg8::Gemm g{xb, win + (size_t)3584 * D, D, D, D, 0, 0, 0, 0, 0}; S.init(128, 12, 1, G, bx); S.uneven = split ? 1 : 0;
      pg8::EpiIn E{ssq, avs, nullptr, nullptr, nullptr, nullptr, nullptr, nullptr, gt, 1};
      pg8::gemm_phase<pg8::EpiIn>(ldsl, g, S, E); } }
__device__ __forceinline__ void run_pf(const Ctx& c, int l) { CTX_PTRS(l)
    pg8::Gemm g{ycat, (const bf16*)(ws + WS_WBT) + (size_t)l * 1024 * 1536, 1536, 1536, 1536, 0, 0, 0, 0, 0}; S.init(128, 4, 1, G, bx);
    pg8::EpiBranch E{gt, (bf16*)(ws + WS_MG)};
    pg8::gemm_phase<pg8::EpiBranch>(ldsl, g, S, E); }
__device__ __forceinline__ void run_pg(const Ctx& c, int l, bool dry = false) { CTX_PTRS(l)
    pg8::Gemm g{(const bf16*)(ws + WS_MG), (const bf16*)(ws + WS_WOT) + (size_t)l * 1024 * 1024, 1024, 1024, 1024, 0, 0, 0, 0, 0}; S.init(128, 4, 1, G, bx);
    pg8::EpiOut E{xb, (l == 0 && !dry) ? (float*)(ws + WS_SSQ1) : nullptr};
    pg8::gemm_phase<pg8::EpiOut>(ldsl, g, S, E); }

template <int L>
__device__ __forceinline__ void layer_phases(const Ctx& c, int lo, int hi, bool coop, const XcdBarrier& bar) {
#define IN(k) (lo <= (k) && (k) < hi)
#define SEAM(k) do { if (coop && IN(k) && IN((k) + 1)) xcd_barrier(bar); } while (0)
    constexpr int P = 1 + 7 * L;
    if (IN(P + 0)) { run_pa(c, L); if (REPM & 1) run_pa(c, L); }
    SEAM(P + 0);
    if (IN(P + 1)) { run_pb(c, L); if (REPM & 2) run_pb(c, L); }
    SEAM(P + 1);
    if (IN(P + 2)) { run_pc(c, L); run_pd(c, L); if (REPM & 8) run_pd(c, L); }
    SEAM(P + 3);
    if (IN(P + 4)) { run_pe(c, L); if (REPM & 16) run_pe(c, L); }
    SEAM(P + 4);
    if (IN(P + 5)) { run_pf(c, L); if (REPM & 32) run_pf(c, L); }
    SEAM(P + 5);
    if (IN(P + 6)) { if ((REPM & 512) && L == 0) run_pg(c, L, true); run_pg(c, L); }
    SEAM(P + 6);
}

__global__ void __launch_bounds__(512, 2) trunk_fwd(Args a) {
    extern __shared__ __attribute__((aligned(16))) unsigned char lds[];
    const int lo = a.ph_lo, hi = a.ph_hi; const bool coop = a.coop != 0;
    const Ctx c{a, lds, (PG8_LAS unsigned char*)lds, (int)gridDim.x, (int)blockIdx.x};
    volatile LAS unsigned* st = (volatile LAS unsigned*)((PG8_LAS unsigned char*)lds + LDS_BYTES - 16);
    if (threadIdx.x == 0) { st[0] = 0u; st[1] = 0u; }
    __syncthreads();
    if (IN(0)) {
        if (blockIdx.x == 0) { unsigned* bw = (unsigned*)(a.ws + WS_BAR); for (int i = threadIdx.x; i < XCD_BAR_WORDS; i += 512) bw[i] = 0u; }
        if (blockIdx.x & 1) { setup_x(a, c.G); phase_setup(a, lds, c.G); } else { phase_setup(a, lds, c.G); setup_x(a, c.G); }
        if (REPM & 64) { phase_setup(a, lds, c.G); setup_x(a, c.G); } }
    XcdBarrier bar; bar.bar = (unsigned*)(a.ws + WS_BAR); bar.x = xb_xcc_id(); bar.st = st;
    if (coop && IN(0) && IN(1)) {
        cg::this_grid().sync();
        if (threadIdx.x == 0) (void)xb_add(&bar.bar[XB_XCNT(bar.x)], 1u);
    }
    if (REPM & 0x100) { if (coop) for (int i = 0; i < 16; ++i) xcd_barrier(bar); }
    layer_phases<0>(c, lo, hi, coop, bar);
    layer_phases<1>(c, lo, hi, coop, bar);
    if (IN(NPH - 1)) phase_final(a, c.G);
#undef IN
#undef SEAM
}

extern "C" void kernel_launch(void* const* d_in, const int* in_sizes, int n_in, void* d_out, int out_size, void* d_ws, size_t ws_size, hipStream_t stream) {
    static int grid = 0;
    if (grid == 0) {
        if (n_in != 22 || out_size != M * D || ws_size < WS_END) { fprintf(stderr, "kernel_launch: unexpected shapes (n_in %d out %d ws %zu)\n", n_in, out_size, ws_size); grid = -1; return; }
        int dev = 0, cus = 0, per_cu = 0;
        hipGetDevice(&dev); hipDeviceGetAttribute(&cus, hipDeviceAttributeMultiprocessorCount, dev);
        if (hipFuncSetAttribute((const void*)trunk_fwd, hipFuncAttributeMaxDynamicSharedMemorySize, LDS_BYTES) != hipSuccess) { fprintf(stderr, "kernel_launch: hipFuncSetAttribute failed\n"); grid = -1; return; }
        if (hipOccupancyMaxActiveBlocksPerMultiprocessor(&per_cu, (const void*)trunk_fwd, 512, LDS_BYTES) != hipSuccess || per_cu < 1) { fprintf(stderr, "kernel_launch: occupancy query says %d\n", per_cu); per_cu = 1; }
        (void)hipGetLastError();
        grid = cus * 1;
        if (grid > cus * per_cu) grid = cus * per_cu;
    }
    if (grid < 0) return;
    Args a{};
    for (int i = 0; i < 22; ++i) a.in[i] = (const float*)d_in[i];
    a.out = (float*)d_out; a.ws = (unsigned char*)d_ws; a.pad = 0;
#if MK_COOP
    a.ph_lo = 0; a.ph_hi = NPH; a.coop = 1;
    void* args[] = {&a};
    hipError_t e = hipLaunchCooperativeKernel((const void*)trunk_fwd, dim3(grid), dim3(512), args, LDS_BYTES, stream);
    if (e != hipSuccess) fprintf(stderr, "cooperative launch failed: %s (grid %d)\n", hipGetErrorString(e), grid);
#else
    for (int ph = 0; ph < NPH; ++ph) { a.ph_lo = ph; a.ph_hi = ph + 1; a.coop = 0; hipLaunchKernelGGL(trunk_fwd, dim3(grid), dim3(512), LDS_BYTES, stream, a); }
#endif
}
```

```cpp
#include <hip/hip_runtime.h>
#include <hip/hip_cooperative_groups.h>
#include <cstdio>
#include <cstdint>
namespace cg = cooperative_groups;

#ifndef REPM
#define REPM 0
#endif
#ifndef MK_COOP
#define MK_COOP 1
#endif

namespace pg8 {
#define PG8_LAS __attribute__((address_space(3)))
typedef unsigned short bf16_t;
typedef short bf16x8 __attribute__((ext_vector_type(8)));
typedef float f32x4 __attribute__((ext_vector_type(4)));
typedef unsigned u32x4 __attribute__((ext_vector_type(4)));
typedef unsigned u32x2 __attribute__((ext_vector_type(2)));
constexpr int BM = 256, BK = 64, HALF = 128, HTB = HALF * BK * 2, STAGE_BYTES = 8 * HTB, NXCD = 8, WGM = 8;

__host__ __device__ __forceinline__ int lds_byte(int r, int c) { const int st = (r >> 4) * 2 + (c >> 5), rr = r & 15, cc = c & 31, ob = rr * 64 + cc * 2; return st * 1024 + (ob ^ (((ob >> 9) & 1) << 5)); }
__host__ __device__ __forceinline__ void stage_rc(int b, int& R, int& C) { const int st = b / 1024, sb = b % 1024, swz = sb ^ (((sb >> 9) & 1) << 5); R = (st >> 1) * 16 + swz / 64; C = (st & 1) * 32 + (swz % 64) / 2; }
__host__ __device__ __forceinline__ int perm32(int rho) { const int n = rho >> 4, i = rho & 15; return 8 * (i >> 2) + 4 * n + (i & 3); }

struct Unit { int pm, pn, bz; };
struct Gemm { const bf16_t* A; const bf16_t* Bt; int lda, ldb, K; long sA, sB; int shA, mskA; long sA2; };

struct Order {
    int nM, nN, nB, nwg, G, c, lim, uneven;
    __device__ void init(int nM_, int nN_, int nB_, int G_, int c_, int lim_ = 0x7fffffff) { nM = nM_; nN = nN_; nB = nB_; nwg = nM * nN * nB; G = G_; c = c_; lim = lim_; uneven = 0; }
    __device__ bool next(int i, Unit& u) const {
        long L = (long)i * G + c;
        if (uneven) { if (i < 5) L = (long)i * 256 + c; else if (c >= 128 && i < 7) L = 1280 + (c - 128) * 2 + (i - 5); else return false; }
        if (L >= nwg || i >= lim) return false;
        int wgid = (int)L;
        if (nB == 1) {
            { const int q = nwg / NXCD, r = nwg % NXCD, xcd = wgid % NXCD, off = wgid / NXCD; wgid = (xcd < r ? xcd * (q + 1) : r * (q + 1) + (xcd - r) * q) + off; }
            const int nig = WGM * nN, gid = wgid / nig, fm = gid * WGM, gsz = (nM - fm) < WGM ? (nM - fm) : WGM;
            u.pm = fm + ((wgid % nig) % gsz); u.pn = (wgid % nig) / gsz; u.bz = 0;
        } else {
            const int per = nM * nN; u.bz = wgid / per; const int r = wgid % per; u.pm = r / nN; u.pn = r % nN;
        }
        return true;
    }
};

__device__ __forceinline__ unsigned cvt_pk_bf16(float lo, float hi) { unsigned r; asm volatile("v_cvt_pk_bf16_f32 %0, %1, %2" : "=v"(r) : "v"(lo), "v"(hi)); return r; }
__device__ __forceinline__ float bflo(unsigned w) { return __uint_as_float(w << 16); }
__device__ __forceinline__ float bfhi(unsigned w) { return __uint_as_float(w & 0xffff0000u); }
__device__ __forceinline__ float sigm(float v) { return __builtin_amdgcn_rcpf(1.0f + __builtin_amdgcn_exp2f(-1.44269504f * v)); }
__device__ __forceinline__ float silu(float v) { return v * sigm(v); }
__device__ __forceinline__ float gelu_t(float v) { const float z = 1.5957691216f * (v + 0.044715f * v * v * v); return v * sigm(z); }
__device__ __forceinline__ u32x4 pack8(const f32x4 a, const f32x4 b) { u32x4 w; w.x = cvt_pk_bf16(a[0], a[1]); w.y = cvt_pk_bf16(a[2], a[3]); w.z = cvt_pk_bf16(b[0], b[1]); w.w = cvt_pk_bf16(b[2], b[3]); return w; }
__device__ __forceinline__ void unpack8(const u32x4 w, f32x4& a, f32x4& b) { a[0] = bflo(w.x); a[1] = bfhi(w.x); a[2] = bflo(w.y); a[3] = bfhi(w.y); b[0] = bflo(w.z); b[1] = bfhi(w.z); b[2] = bflo(w.w); b[3] = bfhi(w.w); }

#define PG8_GAS __attribute__((address_space(1)))
typedef f32x4 Acc[2][2][4][2];

struct EpiIn {
    static constexpr bool PERM = true, AFTER_DRAIN = false, MID = false;
    const float* ssq; bf16_t *avs, *ag, *bv, *bg, *cu, *cv, *cgt, *gt; int mode;
    __device__ __forceinline__ void mid(Acc&, const Unit&, int, int, int, int, int) const {}
    __device__ __forceinline__ void operator()(const Acc& acc, const Unit& u, int wr, int wc, int fr, int fq) const {
        asm volatile("" : "+v"(fr), "+v"(fq));
        const int row0 = u.pm * BM + wr * 64 + fr, colt = u.pn * BM;
        int act, ldo, cb; bf16_t* base; bool isav = false;
        if (mode == 1) { act = 2; base = gt; ldo = 3072; cb = colt; }
        else { const int s = colt >> 9; cb = colt & 511; ldo = 512; act = (s == 1 || s == 3 || s == 6) ? 1 : 0; isav = (s == 0);
               base = s == 1 ? ag : s == 2 ? bv : s == 3 ? bg : s == 4 ? cu : s == 5 ? cv : cgt; }
        float rsv[2][4];
#pragma unroll
        for (int ai = 0; ai < 2; ++ai)
#pragma unroll
            for (int m = 0; m < 4; ++m) rsv[ai][m] = ssq[row0 + ai * HALF + m * 16];
#pragma unroll
        for (int ai = 0; ai < 2; ++ai)
#pragma unroll
            for (int m = 0; m < 4; ++m) {
                const int row = row0 + ai * HALF + m * 16; const float rs = rsqrtf(rsv[ai][m] * (1.0f / 1024.0f) + 1e-6f);
#pragma unroll
                for (int bj = 0; bj < 2; ++bj) {
                    const int col = cb + bj * HALF + wc * 32 + 8 * fq;
                    f32x4 v0 = acc[ai][bj][m][0] * rs, v1 = acc[ai][bj][m][1] * rs;
                    if (act != 0) {
                        f32x4 e0 = v0 * -1.44269504f, e1 = v1 * -1.44269504f;
#pragma unroll
                        for (int j = 0; j < 4; ++j) { e0[j] = __builtin_amdgcn_exp2f(e0[j]); e1[j] = __builtin_amdgcn_exp2f(e1[j]); }
                        e0 = e0 + 1.0f; e1 = e1 + 1.0f;
#pragma unroll
                        for (int j = 0; j < 4; ++j) { e0[j] = __builtin_amdgcn_rcpf(e0[j]); e1[j] = __builtin_amdgcn_rcpf(e1[j]); }
                        if (act == 1) { v0 = v0 * e0; v1 = v1 * e1; } else { v0 = e0; v1 = e1; }
                    }
                    bf16_t* p = isav ? avs + ((size_t)((col >> 5) * 2048 + (row >> 4)) * 768 + ((col >> 4) & 1) * 384 + (row & 15) * 16 + (col & 15))
                                     : base + (size_t)row * ldo + col;
                    *(PG8_GAS u32x4*)p = pack8(v0, v1);
                }
            }
    }
};
struct EpiState {
    static constexpr bool PERM = false, AFTER_DRAIN = false, MID = false;
    float* loc;
    __device__ __forceinline__ void mid(Acc&, const Unit&, int, int, int, int, int) const {}
    __device__ __forceinline__ void operator()(const Acc& acc, const Unit& u, int wr, int wc, int fr, int fq) const {
        asm volatile("" : "+v"(fr), "+v"(fq));
        const int row0 = u.pm * BM + wr * 64 + fr, col0 = wc * 32 + 4 * fq;
#pragma unroll
        for (int ai = 0; ai < 2; ++ai)
#pragma unroll
            for (int m = 0; m < 4; ++m) { float* rp = loc + ((size_t)u.bz * 2048 + row0 + ai * HALF + m * 16) * 256 + col0;
#pragma unroll
                for (int bj = 0; bj < 2; ++bj)
#pragma unroll
                    for (int n = 0; n < 2; ++n) *(PG8_GAS f32x4*)(rp + bj * HALF + n * 16) = acc[ai][bj][m][n]; }
    }
};
struct EpiToep {
    static constexpr bool PERM = true, AFTER_DRAIN = false, MID = false;
    const bf16_t* avs; const float* dsk; bf16_t* yg;
    __device__ __forceinline__ void mid(Acc&, const Unit&, int, int, int, int, int) const {}
    __device__ __forceinline__ void operator()(const Acc& acc, const Unit& u, int wr, int wc, int fr, int fq) const {
        asm volatile("" : "+v"(fr), "+v"(fq));
        const int g = u.bz, row0 = u.pm * BM + wr * 64 + fr;
        const bf16_t* ub = avs + (size_t)(g >> 1) * 2048 * 768 + (g & 1) * 384;
        const int c0 = (8 * fq) & 15;
        const f32x4 d0 = *(const PG8_GAS f32x4*)(dsk + g * 16 + c0), d1 = *(const PG8_GAS f32x4*)(dsk + g * 16 + c0 + 4);
#pragma unroll
        for (int ai = 0; ai < 2; ++ai) {
            u32x4 uq[4][2];
#pragma unroll
            for (int m = 0; m < 4; ++m)
#pragma unroll
                for (int bj = 0; bj < 2; ++bj) uq[m][bj] = *(const PG8_GAS u32x4*)(ub + (size_t)(row0 + ai * HALF + m * 16) * 768 + bj * HALF + wc * 32 + 8 * fq);
#pragma unroll
            for (int m = 0; m < 4; ++m) { const int sc = row0 + ai * HALF + m * 16;
#pragma unroll
                for (int bj = 0; bj < 2; ++bj) { const int col = bj * HALF + wc * 32 + 8 * fq;
                    f32x4 u0, u1; unpack8(uq[m][bj], u0, u1);
                    f32x4 v0 = acc[ai][bj][m][0] + d0 * u0, v1 = acc[ai][bj][m][1] + d1 * u1;
#pragma unroll
                    for (int j = 0; j < 4; ++j) { v0[j] = gelu_t(v0[j]); v1[j] = gelu_t(v1[j]); }
                    *(PG8_GAS u32x4*)(yg + (size_t)(sc * 16 + (col >> 4)) * 512 + g * 16 + c0) = pack8(v0, v1); } }
        }
    }
};
struct EpiGlu {
    static constexpr bool PERM = true, AFTER_DRAIN = false, MID = false;
    const bf16_t *yg, *ag; const float* bias; bf16_t* ycat;
    __device__ __forceinline__ void mid(Acc&, const Unit&, int, int, int, int, int) const {}
    __device__ __forceinline__ void operator()(const Acc& acc, const Unit& u, int wr, int wc, int fr, int fq) const {
        asm volatile("" : "+v"(fr), "+v"(fq));
        const int row0 = u.pm * BM + wr * 64 + fr, col0 = u.pn * BM + wc * 32 + 8 * fq;
        f32x4 bq[2][2];
#pragma unroll
        for (int bj = 0; bj < 2; ++bj) { bq[bj][0] = *(const PG8_GAS f32x4*)(bias + col0 + bj * HALF); bq[bj][1] = *(const PG8_GAS f32x4*)(bias + col0 + bj * HALF + 4); }
#pragma unroll
        for (int ai = 0; ai < 2; ++ai) {
            u32x4 yq[4][2], gq[4][2];
#pragma unroll
            for (int m = 0; m < 4; ++m)
#pragma unroll
                for (int bj = 0; bj < 2; ++bj) { const size_t o = (size_t)(row0 + ai * HALF + m * 16) * 512 + col0 + bj * HALF; yq[m][bj] = *(const PG8_GAS u32x4*)(yg + o); gq[m][bj] = *(const PG8_GAS u32x4*)(ag + o); }
#pragma unroll
            for (int m = 0; m < 4; ++m) { const size_t row = row0 + ai * HALF + m * 16;
#pragma unroll
                for (int bj = 0; bj < 2; ++bj) { const int col = col0 + bj * HALF;
                    const f32x4 b0 = bq[bj][0], b1 = bq[bj][1];
                    f32x4 y0, y1, g0, g1; unpack8(yq[m][bj], y0, y1); unpack8(gq[m][bj], g0, g1);
                    f32x4 v0 = acc[ai][bj][m][0] + b0, v1 = acc[ai][bj][m][1] + b1;
#pragma unroll
                    for (int j = 0; j < 4; ++j) { v0[j] = y0[j] * sigm(v0[j]) * g0[j]; v1[j] = y1[j] * sigm(v1[j]) * g1[j]; }
                    *(PG8_GAS u32x4*)(ycat + row * 1536 + col) = pack8(v0, v1); } }
        }
    }
};
struct EpiPool {
    static constexpr bool PERM = true, AFTER_DRAIN = false, MID = false;
    const bf16_t* bg; const float* scale; bf16_t* ycat;
    __device__ __forceinline__ void mid(Acc&, const Unit&, int, int, int, int, int) const {}
    __device__ __forceinline__ void operator()(const Acc& acc, const Unit& u, int wr, int wc, int fr, int fq) const {
        asm volatile("" : "+v"(fr), "+v"(fq));
        const int row0 = u.pm * BM + wr * 64 + fr, col0 = u.bz * 256 + wc * 32 + 8 * fq;
#pragma unroll
        for (int ai = 0; ai < 2; ++ai)
#pragma unroll
            for (int m = 0; m < 4; ++m) { const size_t row = row0 + ai * HALF + m * 16;
#pragma unroll
                for (int bj = 0; bj < 2; ++bj) { const int col = col0 + bj * HALF;
                    const f32x4 s0 = *(const PG8_GAS f32x4*)(scale + col), s1 = *(const PG8_GAS f32x4*)(scale + col + 4);
                    f32x4 g0, g1; unpack8(*(const PG8_GAS u32x4*)(bg + row * 512 + col), g0, g1);
                    const f32x4 v0 = acc[ai][bj][m][0] * s0 * g0, v1 = acc[ai][bj][m][1] * s1 * g1;
                    *(PG8_GAS u32x4*)(ycat + row * 1536 + 512 + col) = pack8(v0, v1); } }
    }
};
struct EpiSgu {
    static constexpr bool PERM = false, AFTER_DRAIN = true, MID = false;
    const bf16_t *cu, *cgt; const float* sb; bf16_t* ycat;
    __device__ __forceinline__ void mid(Acc&, const Unit&, int, int, int, int, int) const {}
    __device__ __forceinline__ void operator()(const Acc& acc, const Unit& u, int wr, int wc, int fr, int fq) const {
        asm volatile("" : "+v"(fr), "+v"(fq));
#pragma unroll
        for (int ai = 0; ai < 2; ++ai)
#pragma unroll
            for (int m = 0; m < 4; ++m) { const int blk = u.pm * 2 + ai, c = wr * 64 + m * 16 + fr;
#pragma unroll
                for (int bj = 0; bj < 2; ++bj) { const int h = u.bz * 2 + bj, ch = h * 128 + c;
#pragma unroll
                    for (int n = 0; n < 2; ++n) { const int t0 = wc * 32 + 16 * n + 4 * fq; const f32x4 bs = *(const PG8_GAS f32x4*)(sb + h * 128 + t0);
#pragma unroll
                        for (int j = 0; j < 4; ++j) { const size_t tok = (size_t)blk * 128 + t0 + j;
                            const float uu = __uint_as_float((unsigned)cu[tok * 512 + ch] << 16), gg = __uint_as_float((unsigned)cgt[tok * 512 + ch] << 16);
                            const float v = uu * (acc[ai][bj][m][n][j] + bs[j]) * gg;
                            ycat[tok * 1536 + 1024 + ch] = (bf16_t)(cvt_pk_bf16(v, 0.f) & 0xffffu); } } } }
    }
    __device__ __forceinline__ void fused(const Acc& acc, const Unit& u, int wr, int wc, int fr, int fq, PG8_LAS unsigned char* lds, int tid) const {
        asm volatile("" : "+v"(fr), "+v"(fq), "+v"(tid));
        PG8_LAS float* T = (PG8_LAS float*)lds;
#pragma unroll
        for (int ai = 0; ai < 2; ++ai) {
#pragma unroll
            for (int m = 0; m < 4; ++m)
#pragma unroll
                for (int bj = 0; bj < 2; ++bj)
#pragma unroll
                    for (int n = 0; n < 2; ++n)
#pragma unroll
                        for (int j = 0; j < 4; ++j) T[(bj * 128 + wc * 32 + 16 * n + 4 * fq + j) * 132 + wr * 64 + m * 16 + fr] = acc[ai][bj][m][n][j];
            __syncthreads();
            const int blk = u.pm * 2 + ai;
#pragma unroll 2
            for (int it = 0; it < 8; ++it) { const int item = it * 512 + tid, tt = item >> 4, cc = (item & 15) * 8, t = tt & 127, h = u.bz * 2 + (tt >> 7);
                const size_t tok = (size_t)blk * 128 + t; const int ch = h * 128 + cc;
                const f32x4 z0 = *(const PG8_LAS f32x4*)(T + tt * 132 + cc), z1 = *(const PG8_LAS f32x4*)(T + tt * 132 + cc + 4);
                const float bs = sb[h * 128 + t];
                f32x4 u0, u1, g0, g1; unpack8(*(const PG8_GAS u32x4*)(cu + tok * 512 + ch), u0, u1); unpack8(*(const PG8_GAS u32x4*)(cgt + tok * 512 + ch), g0, g1);
                const f32x4 v0 = u0 * (z0 + bs) * g0, v1 = u1 * (z1 + bs) * g1;
                *(PG8_GAS u32x4*)(ycat + tok * 1536 + 1024 + ch) = pack8(v0, v1); }
            __syncthreads();
        }
    }
};
struct EpiBranch {
    static constexpr bool PERM = true, AFTER_DRAIN = false, MID = true;
    const bf16_t* gt; bf16_t* mg;
    __device__ __forceinline__ void mid(Acc& acc, const Unit& u, int kb, int wr, int wc, int fr, int fq) const {
        asm volatile("" : "+v"(fr), "+v"(fq));
        const int row0 = u.pm * BM + wr * 64 + fr, col0 = u.pn * BM + wc * 32 + 8 * fq;
#pragma unroll
        for (int ai = 0; ai < 2; ++ai)
#pragma unroll
            for (int m = 0; m < 4; ++m) { const bf16_t* rp = gt + (size_t)(row0 + ai * HALF + m * 16) * 3072 + kb * 1024 + col0;
#pragma unroll
                for (int bj = 0; bj < 2; ++bj) { f32x4 a0, a1, b0, b1; unpack8(*(const PG8_GAS u32x4*)(rp + bj * HALF), a0, a1); unpack8(*(const PG8_GAS u32x4*)(rp + 1024 + bj * HALF), b0, b1);
#pragma unroll
                    for (int j = 0; j < 4; ++j) { acc[ai][bj][m][0][j] *= a0[j] * __builtin_amdgcn_rcpf(b0[j]); acc[ai][bj][m][1][j] *= a1[j] * __builtin_amdgcn_rcpf(b1[j]); } } }
    }
    __device__ __forceinline__ void operator()(const Acc& acc, const Unit& u, int wr, int wc, int fr, int fq) const {
        asm volatile("" : "+v"(fr), "+v"(fq));
        const int row0 = u.pm * BM + wr * 64 + fr, col0 = u.pn * BM + wc * 32 + 8 * fq;
#pragma unroll
        for (int ai = 0; ai < 2; ++ai) {
            u32x4 gq[4][2];
#pragma unroll
            for (int m = 0; m < 4; ++m)
#pragma unroll
                for (int bj = 0; bj < 2; ++bj) gq[m][bj] = *(const PG8_GAS u32x4*)(gt + (size_t)(row0 + ai * HALF + m * 16) * 3072 + 2048 + col0 + bj * HALF);
#pragma unroll
            for (int m = 0; m < 4; ++m) { const size_t row = row0 + ai * HALF + m * 16;
#pragma unroll
                for (int bj = 0; bj < 2; ++bj) { f32x4 a0, a1; unpack8(gq[m][bj], a0, a1);
                    *(PG8_GAS u32x4*)(mg + row * 1024 + col0 + bj * HALF) = pack8(acc[ai][bj][m][0] * a0, acc[ai][bj][m][1] * a1); } }
        }
    }
};
struct EpiOut {
    static constexpr bool PERM = true, AFTER_DRAIN = false, MID = false;
    bf16_t* xb; float* ssq;
    __device__ __forceinline__ void mid(Acc&, const Unit&, int, int, int, int, int) const {}
    __device__ __forceinline__ void operator()(const Acc& acc, const Unit& u, int wr, int wc, int fr, int fq) const {
        asm volatile("" : "+v"(fr), "+v"(fq));
        const int row0 = u.pm * BM + wr * 64 + fr, col0 = u.pn * BM + wc * 32 + 8 * fq;
#pragma unroll
        for (int ai = 0; ai < 2; ++ai) {
            u32x4 q[4][2];
#pragma unroll
            for (int m = 0; m < 4; ++m)
#pragma unroll
                for (int bj = 0; bj < 2; ++bj) q[m][bj] = *(const PG8_GAS u32x4*)(xb + (size_t)(row0 + ai * HALF + m * 16) * 1024 + col0 + bj * HALF);
#pragma unroll
            for (int m = 0; m < 4; ++m) { const size_t row = row0 + ai * HALF + m * 16; float s = 0.f;
#pragma unroll
                for (int bj = 0; bj < 2; ++bj) { f32x4 x0, x1; unpack8(q[m][bj], x0, x1);
                    const f32x4 v0 = x0 + acc[ai][bj][m][0], v1 = x1 + acc[ai][bj][m][1];
                    *(PG8_GAS u32x4*)(xb + row * 1024 + col0 + bj * HALF) = pack8(v0, v1);
                    s += ((v0[0] * v0[0] + v0[1] * v0[1]) + (v0[2] * v0[2] + v0[3] * v0[3])) + ((v1[0] * v1[0] + v1[1] * v1[1]) + (v1[2] * v1[2] + v1[3] * v1[3])); }
                if (ssq) { s += __shfl_xor(s, 16); s += __shfl_xor(s, 32); if (fq == 0) unsafeAtomicAdd(ssq + row, s); } }
        }
    }
};

template <class Epi>
__device__ __forceinline__ void gemm_phase(PG8_LAS unsigned char* lds, const Gemm g, const Order& S, const Epi& E) {
    int tid = threadIdx.x; asm volatile("" : "+v"(tid));
    const int wid = __builtin_amdgcn_readfirstlane(tid >> 6), lane = tid & 63, wr = wid >> 2, wc = wid & 3, fr = lane & 15, fq = lane >> 4;
    const int nt = g.K / BK;
    unsigned voffA[2], voffB[2];
#pragma unroll
    for (int i = 0; i < 2; ++i) { int R, C; stage_rc(tid * 16 + i * 8192, R, C); const int Rb = Epi::PERM ? ((R & ~31) + perm32(R & 31)) : R;
        voffA[i] = (unsigned)(R * g.lda + C) * 2u; voffB[i] = (unsigned)(Rb * g.ldb + C) * 2u; }
    const size_t kstep = (size_t)(BK * 2);
    const size_t hstepA = (size_t)HALF * g.lda * 2, hstepB = (size_t)HALF * g.ldb * 2;
    const unsigned ldsw = (unsigned)wid * 1024u;
    const int aoff = lds_byte(wr * 64 + fr, fq * 8), boff = lds_byte(wc * 32 + fr, fq * 8);
#define PG8_SA(b, h) (((b) * 2 + (h)) * HTB)
#define PG8_SB(b, h) ((4 + (b) * 2 + (h)) * HTB)
#define PG8_STAGE(bufoff, gbase, voff) do { _Pragma("unroll") for (int _i = 0; _i < 2; ++_i) \
        __builtin_amdgcn_global_load_lds((const unsigned*)((const char*)(gbase) + (voff)[_i]), (PG8_LAS unsigned*)(lds + (bufoff) + ldsw + _i * 8192), 16, 0, 0); } while (0)
#define PG8_LDA(dst, b, h) do { _Pragma("unroll") for (int m = 0; m < 4; ++m) _Pragma("unroll") for (int k = 0; k < 2; ++k) dst[m][k] = *(const PG8_LAS bf16x8*)(lds + PG8_SA(b, h) + aoff + m * 2048 + k * 1024); } while (0)
#define PG8_LDB(dst, b, h) do { _Pragma("unroll") for (int n = 0; n < 2; ++n) _Pragma("unroll") for (int k = 0; k < 2; ++k) dst[n][k] = *(const PG8_LAS bf16x8*)(lds + PG8_SB(b, h) + boff + n * 2048 + k * 1024); } while (0)
#define PG8_MMA(ai, bj, At, Bt) do { __builtin_amdgcn_s_setprio(1); _Pragma("unroll") for (int m = 0; m < 4; ++m) _Pragma("unroll") for (int n = 0; n < 2; ++n) _Pragma("unroll") for (int k = 0; k < 2; ++k) \
        acc[ai][bj][m][n] = __builtin_amdgcn_mfma_f32_16x16x32_bf16(Bt[n][k], At[m][k], acc[ai][bj][m][n], 0, 0, 0); __builtin_amdgcn_s_setprio(0); } while (0)
#define PG8_WAIT_V(n) asm volatile("s_waitcnt vmcnt(" #n ")" ::: "memory")
#define PG8_WAIT_L(n) asm volatile("s_waitcnt lgkmcnt(" #n ")" ::: "memory")
#define PG8_BAR __builtin_amdgcn_s_barrier()
#define PG8_SCHED __builtin_amdgcn_sched_barrier(0)
#define PG8_UA(u) ((const char*)g.A + ((size_t)((u).bz >> g.shA) * g.sA + (size_t)((u).bz & g.mskA) * g.sA2 + (size_t)(u).pm * BM * g.lda) * 2)
#define PG8_UB(u) ((const char*)g.Bt + ((size_t)(u).bz * g.sB + (size_t)(u).pn * BM * g.ldb) * 2)
    Unit cur, nxt; int ui = 0;
    if (!S.next(0, cur)) return;
    Acc acc;
#pragma unroll
    for (int a = 0; a < 2; ++a)
#pragma unroll
        for (int b = 0; b < 2; ++b)
#pragma unroll
            for (int m = 0; m < 4; ++m)
#pragma unroll
                for (int n = 0; n < 2; ++n) acc[a][b][m][n] = (f32x4){0.f, 0.f, 0.f, 0.f};
    bf16x8 At[4][2], B0[2][2], B1[2][2];
    const char* cA = PG8_UA(cur); const char* cB = PG8_UB(cur);
    PG8_STAGE(PG8_SB(0, 0), cB, voffB); PG8_STAGE(PG8_SB(0, 1), cB + hstepB, voffB); PG8_STAGE(PG8_SA(0, 0), cA, voffA); PG8_STAGE(PG8_SA(0, 1), cA + hstepA, voffA);
    if (wr == 1) PG8_BAR;
    PG8_WAIT_V(2); PG8_BAR;
    PG8_STAGE(PG8_SB(1, 0), cB + kstep, voffB); PG8_STAGE(PG8_SA(1, 0), cA + kstep, voffA); PG8_STAGE(PG8_SB(1, 1), cB + hstepB + kstep, voffB);
    PG8_WAIT_V(6); PG8_BAR;
    for (;;) {
        const bool has_next = S.next(ui + 1, nxt);
        const char* nA = has_next ? PG8_UA(nxt) : cA; const char* nB = has_next ? PG8_UB(nxt) : cB;
#pragma unroll 1
        for (int t = 0; t < nt; t += 2) {
            const bool last = (t == nt - 2);
            const char* a1 = cA + (size_t)(t + 1) * kstep;
            const char* a2 = last ? nA : cA + (size_t)(t + 2) * kstep; const char* b2 = last ? nB : cB + (size_t)(t + 2) * kstep;
            const char* a3 = a2 + kstep; const char* b3 = b2 + kstep;
            PG8_LDB(B0, 0, 0); PG8_LDB(B1, 0, 1); PG8_SCHED; PG8_LDA(At, 0, 0); PG8_STAGE(PG8_SA(1, 1), a1 + hstepA, voffA);
            PG8_WAIT_V(8); PG8_WAIT_L(0); PG8_BAR; PG8_MMA(0, 0, At, B0); PG8_MMA(0, 1, At, B1); PG8_BAR; PG8_SCHED;
            PG8_LDA(At, 0, 1); PG8_STAGE(PG8_SB(0, 0), b2, voffB); PG8_STAGE(PG8_SB(0, 1), b2 + hstepB, voffB); PG8_STAGE(PG8_SA(0, 0), a2, voffA);
            PG8_WAIT_V(8); PG8_WAIT_L(0); PG8_BAR; PG8_MMA(1, 0, At, B0); PG8_MMA(1, 1, At, B1); PG8_BAR; PG8_SCHED;
            PG8_LDB(B0, 1, 0); PG8_LDB(B1, 1, 1); PG8_SCHED; PG8_LDA(At, 1, 0); PG8_STAGE(PG8_SA(0, 1), a2 + hstepA, voffA);
            PG8_WAIT_V(8); PG8_WAIT_L(0); PG8_BAR; PG8_MMA(0, 0, At, B0); PG8_MMA(0, 1, At, B1); PG8_BAR; PG8_SCHED;
            PG8_LDA(At, 1, 1); PG8_STAGE(PG8_SB(1, 0), b3, voffB); PG8_STAGE(PG8_SB(1, 1), b3 + hstepB, voffB); PG8_STAGE(PG8_SA(1, 0), a3, voffA);
            PG8_WAIT_V(8); PG8_WAIT_L(0); PG8_BAR; PG8_MMA(1, 0, At, B0); PG8_MMA(1, 1, At, B1); PG8_BAR; PG8_SCHED;
            if constexpr (Epi::MID) { if (((t + 2) & 7) == 0 && !last) { E.mid(acc, cur, ((t + 2) >> 3) - 1, wr, wc, fr, fq); PG8_SCHED; } }
        }
        if (wr == 0) PG8_BAR;
        if constexpr (Epi::AFTER_DRAIN) { if (has_next) E(acc, cur, wr, wc, fr, fq); } else E(acc, cur, wr, wc, fr, fq);
        if (!has_next) break;
#pragma unroll
        for (int a = 0; a < 2; ++a)
#pragma unroll
            for (int b = 0; b < 2; ++b)
#pragma unroll
                for (int m = 0; m < 4; ++m)
#pragma unroll
                    for (int n = 0; n < 2; ++n) acc[a][b][m][n] = (f32x4){0.f, 0.f, 0.f, 0.f};
        cur = nxt; cA = nA; cB = nB; ++ui;
        if (wr == 1) PG8_BAR;
    }
    PG8_WAIT_V(0);
    PG8_BAR;
    if constexpr (Epi::AFTER_DRAIN) E.fused(acc, cur, wr, wc, fr, fq, lds, tid);
#undef PG8_SA
#undef PG8_SB
#undef PG8_STAGE
#undef PG8_LDA
#undef PG8_LDB
#undef PG8_MMA
#undef PG8_WAIT_V
#undef PG8_WAIT_L
#undef PG8_BAR
#undef PG8_SCHED
#undef PG8_UA
#undef PG8_UB
}
}

typedef unsigned short bf16;
typedef unsigned v4u __attribute__((ext_vector_type(4)));
typedef float f32x4 __attribute__((ext_vector_type(4)));
#define LAS __attribute__((address_space(3)))
constexpr int M = 32768, D = 1024, DIN = 6656, DBR = 512, SEQ = 2048;
constexpr int LDS_BYTES = 147456;
constexpr int NPH = 16;
constexpr size_t MiB = 1u << 20;
constexpr size_t WS_SSQ0 = 0, WS_SSQ1 = 128 * 1024, WS_BAR = 512 * 1024;
constexpr size_t WS_WIN = 1 * MiB, WS_WGLU = 27 * MiB, WS_WBT = 28 * MiB, WS_WOT = 34 * MiB, WS_PWT = 38 * MiB, WS_SWT = 38 * MiB + 512 * 1024, WS_WST = 39 * MiB, WS_TP = 51 * MiB;
constexpr size_t WS_XB = 64 * MiB, WS_YCAT = 128 * MiB, WS_AG = 224 * MiB, WS_MG = 224 * MiB, WS_BV = 256 * MiB, WS_YG = 256 * MiB, WS_AVS = 288 * MiB, WS_GT = 288 * MiB,
                 WS_LOC = 336 * MiB, WS_BG = 368 * MiB, WS_CU = 400 * MiB, WS_CV = 432 * MiB, WS_CG = 464 * MiB, WS_END = 496 * MiB;

__device__ __forceinline__ unsigned f2bf(float f) { unsigned u = __builtin_bit_cast(unsigned, f); return (u + 0x7fffu + ((u >> 16) & 1u)) >> 16; }
__device__ __forceinline__ unsigned pk2(float lo, float hi) { return f2bf(lo) | (f2bf(hi) << 16); }
__device__ __forceinline__ float wave_sum(float v) {
#pragma unroll
    for (int o = 1; o < 64; o <<= 1) v += __shfl_xor(v, o);
    return v;
}
__device__ __forceinline__ double exp_small(double x) {
    double r = 1.0;
#pragma unroll
    for (int i = 22; i >= 1; --i) r = 1.0 + r * x * (1.0 / (double)i);
    return r;
}
__device__ __forceinline__ void sincos_rev(double rev, double& s, double& c) {
    double f = rev - floor(rev + 0.5);
    const double th = f * 6.283185307179586476925;
    const double t2 = th * th; double ss = 1.0, cc = 1.0;
#pragma unroll
    for (int i = 14; i >= 1; --i) { ss = 1.0 - ss * t2 * (1.0 / (double)((2 * i) * (2 * i + 1))); cc = 1.0 - cc * t2 * (1.0 / (double)((2 * i - 1) * (2 * i))); }
    s = th * ss; c = cc;
}
__device__ __forceinline__ void apow(double lr, double li, double dt, int d, double& re, double& im) {
    const double mag = exp_small(lr * dt * (double)d); double s, c; sincos_rev(li * dt * (double)d * 0.15915494309189533577, s, c);
    re = mag * c; im = mag * s;
}

__device__ __forceinline__ void p0_transpose_item(const float* W, int N, bf16* WT, int ldt, int koff, const float* gk, float* scr, int item, int lane) {
    const int nblk = N / 32, kb = item / nblk, nb = item % nblk, k0 = 64 * kb, n0 = 32 * nb;
#pragma unroll
    for (int i = 0; i < 32; ++i) { const int kk = 2 * i + (lane >> 5); float v = W[(size_t)(k0 + kk) * N + n0 + (lane & 31)]; if (gk) v *= gk[k0 + kk]; scr[kk * 33 + (lane & 31)] = v; }
    asm volatile("s_waitcnt lgkmcnt(0)" ::: "memory");
    const int c = lane & 7;
#pragma unroll
    for (int j = 0; j < 4; ++j) { const int n = (lane >> 3) + 8 * j; const float* s = scr + (8 * c) * 33 + n;
        v4u o; o.x = pk2(s[0 * 33], s[1 * 33]); o.y = pk2(s[2 * 33], s[3 * 33]); o.z = pk2(s[4 * 33], s[5 * 33]); o.w = pk2(s[6 * 33], s[7 * 33]);
        *(v4u*)(WT + (size_t)(n0 + n) * ldt + koff + k0 + 8 * c) = o; }
    asm volatile("s_waitcnt lgkmcnt(0)" ::: "memory");
}

struct Args { const float* in[22]; float* out; unsigned char* ws; int ph_lo, ph_hi, coop, pad; };
enum { I_X = 0, I_NG, I_WIN, I_LRE, I_LIM, I_LDT, I_BRE, I_BIM, I_CRE, I_CIM, I_SD, I_WGLU, I_BGLU, I_PW, I_PS, I_LNG, I_LNB, I_SW, I_SB, I_WB, I_WO, I_FG };

__device__ __forceinline__ void setup_x(const Args& a, int G) {
    const int tid = threadIdx.x, lane = tid & 63, wave = tid >> 6, bx = blockIdx.x;
    unsigned char* ws = a.ws;
    {
        const int gw = bx * 8 + wave, NGW = G * 8;
        float* ssq0 = (float*)(ws + WS_SSQ0); float* ssq1 = (float*)(ws + WS_SSQ1);
        bf16* xb = (bf16*)(ws + WS_XB);
        f32x4 v[4][4];
#pragma unroll
        for (int r = 0; r < 4; ++r) { const int mr = gw + r * NGW; const f32x4* xr = (const f32x4*)(a.in[I_X] + (size_t)(mr < M ? mr : gw) * D) + lane;
#pragma unroll
            for (int j = 0; j < 4; ++j) v[r][j] = xr[64 * j]; }
        for (int m = gw; m < M; m += 4 * NGW) {
            f32x4 w[4][4]; const int mn = m + 4 * NGW;
            if (mn < M) {
#pragma unroll
                for (int r = 0; r < 4; ++r) { const int mr = mn + r * NGW; const f32x4* xr = (const f32x4*)(a.in[I_X] + (size_t)(mr < M ? mr : mn) * D) + lane;
#pragma unroll
                    for (int j = 0; j < 4; ++j) w[r][j] = xr[64 * j]; }
            } else {
#pragma unroll
                for (int r = 0; r < 4; ++r)
#pragma unroll
                    for (int j = 0; j < 4; ++j) w[r][j] = v[r][j];
            }
            float sq[4];
#pragma unroll
            for (int r = 0; r < 4; ++r) { float s = 0.f;
#pragma unroll
                for (int j = 0; j < 4; ++j) s += (v[r][j].x * v[r][j].x + v[r][j].y * v[r][j].y) + (v[r][j].z * v[r][j].z + v[r][j].w * v[r][j].w);
                sq[r] = wave_sum(s); }
#pragma unroll
            for (int r = 0; r < 4; ++r) { const int mr = m + r * NGW;
                if (mr < M) { unsigned long long* o8 = (unsigned long long*)(xb + (size_t)mr * D) + lane;
#pragma unroll
                    for (int j = 0; j < 4; ++j) o8[64 * j] = (unsigned long long)pk2(v[r][j].x, v[r][j].y) | ((unsigned long long)pk2(v[r][j].z, v[r][j].w) << 32);
                    if (lane == 0) { ssq0[mr] = sq[r]; ssq1[mr] = 0.f; } } }
#pragma unroll
            for (int r = 0; r < 4; ++r)
#pragma unroll
                for (int j = 0; j < 4; ++j) v[r][j] = w[r][j];
        }
    }
}

__device__ __forceinline__ void phase_setup(const Args& a, unsigned char* lds, int G) {
    const int tid = threadIdx.x, lane = tid & 63, wave = tid >> 6, bx = blockIdx.x;
    unsigned char* ws = a.ws;
    for (int task = bx; task < 256; task += G) {
        const int part = task & 3, l = task >> 7, g = (task >> 2) & 31;
        float* Ere = (float*)lds;
        float* Eim = Ere + 64 * 17;
        float* Bre = Eim + 64 * 17;
        float* Bim = Bre + 64 * 16;
        float* Cre = Bim + 64 * 16;
        float* Cim = Cre + 16 * 65;
        float* Kt = Cim + 16 * 65;
        const double dt = exp_small(0.25 * (double)a.in[I_LDT][l * 32 + g]);
        const double dtt = (dt * dt) * (dt * dt);
        const float* lre = a.in[I_LRE] + (l * 32 + g) * 64; const float* lim = a.in[I_LIM] + (l * 32 + g) * 64;
        for (int idx = tid; idx < 64 * 17; idx += 512) { const int p = idx / 17, d = idx % 17; double re, im; apow((double)lre[p], (double)lim[p], dtt, d, re, im); Ere[idx] = (float)re; Eim[idx] = (float)im; }
        for (int idx = tid; idx < 64 * 16; idx += 512) { const int p = idx >> 4;
            const double lr = (double)lre[p], li = (double)lim[p]; double are, aim; apow(lr, li, dtt, 1, are, aim);
            const double nr = are - 1.0, ni = aim, den = lr * lr + li * li, kre = (nr * lr + ni * li) / den, kim = (ni * lr - nr * li) / den;
            const double br = (double)a.in[I_BRE][(size_t)(l * 32 + g) * 1024 + idx], bi = (double)a.in[I_BIM][(size_t)(l * 32 + g) * 1024 + idx];
            Bre[idx] = (float)(kre * br - kim * bi); Bim[idx] = (float)(kre * bi + kim * br); }
        for (int idx = tid; idx < 1024; idx += 512) { const int o = (idx >> 6) * 65 + (idx & 63); Cre[o] = a.in[I_CRE][(size_t)(l * 32 + g) * 1024 + idx]; Cim[o] = a.in[I_CIM][(size_t)(l * 32 + g) * 1024 + idx]; }
        __syncthreads();
        if (part < 2) {
            { const int ph = tid & 1, co = (tid >> 1) & 15, d = tid >> 5;
              float sacc[16];
#pragma unroll
              for (int q = 0; q < 16; ++q) sacc[q] = 0.f;
              for (int p = ph * 32; p < ph * 32 + 32; ++p) {
                  const float er = Ere[p * 17 + d], ei = Eim[p * 17 + d], cr = Cre[co * 65 + p], cim = Cim[co * 65 + p];
                  const float cer = cr * er - cim * ei, cei = cr * ei + cim * er;
                  const f32x4* br4 = (const f32x4*)(Bre + p * 16); const f32x4* bi4 = (const f32x4*)(Bim + p * 16);
#pragma unroll
                  for (int q = 0; q < 4; ++q) { const f32x4 br = br4[q], bi = bi4[q];
#pragma unroll
                      for (int e = 0; e < 4; ++e) sacc[q * 4 + e] += cer * br[e] - cei * bi[e]; } }
#pragma unroll
              for (int q = 0; q < 16; ++q) sacc[q] += __shfl_xor(sacc[q], 1);
              if (ph == 0) {
#pragma unroll
                  for (int q = 0; q < 4; ++q) *(f32x4*)(Kt + (d << 8) + (co << 4) + q * 4) = (f32x4){sacc[q * 4], sacc[q * 4 + 1], sacc[q * 4 + 2], sacc[q * 4 + 3]}; } }
            __syncthreads();
            bf16* tp = (bf16*)(ws + WS_TP) + (size_t)(l * 32 + g) * 256 * 384;
            for (int i = 0; i < 32; ++i) { const int row = part * 128 + 4 * i + (tid >> 7), t = row >> 4, co = row & 15;
#pragma unroll
                for (int j = 0; j < 3; ++j) { const int k = (tid & 127) + 128 * j; float v;
                    if (j < 2) { const int sx = k >> 4, ci = k & 15; v = (sx <= t) ? Kt[((t - sx) << 8) + (co << 4) + ci] : 0.f; }
                    else { const int jj = k - 256, p = jj & 63; const float er = Ere[p * 17 + t + 1], ei = Eim[p * 17 + t + 1], cr = Cre[co * 65 + p], ci_ = Cim[co * 65 + p];
                           v = (jj < 64) ? (cr * er - ci_ * ei) : -(cr * ei + ci_ * er); }
                    tp[(size_t)row * 384 + k] = (bf16)f2bf(v); } }
        } else {
            bf16* wst = (bf16*)(ws + WS_WST) + ((size_t)(l * 16 + (g >> 1)) * 256 + (g & 1) * 128) * 768;
            for (int i = 0; i < 16; ++i) { const int jrow = (part - 2) * 64 + 4 * i + (tid >> 7), p = jrow & 63;
#pragma unroll
                for (int j = 0; j < 6; ++j) { const int col = (tid & 127) + 128 * j, gl2 = j / 3, k = col - gl2 * 384; float v = 0.f;
                    if (gl2 == (g & 1) && k < 256) { const int sx = k >> 4, cx = k & 15; const float er = Ere[p * 17 + 15 - sx], ei = Eim[p * 17 + 15 - sx], br = Bre[p * 16 + cx], bi = Bim[p * 16 + cx];
                        v = (jrow < 64) ? (er * br - ei * bi) : (er * bi + ei * br); }
                    wst[(size_t)jrow * 768 + col] = (bf16)f2bf(v); } }
        }
        __syncthreads();
    }
    {
        constexpr int I_IN = 16 * 26, I_GL = 8 * 2, I_BR = 8 * 4, I_OU = 16 * 4, PER = I_IN + I_GL + 3 * I_BR + I_OU;
        for (int it = bx; it < 2 * PER; it += G) {
            const int l = it / PER; int r = it % PER;
            const float* W; int N; bf16* WT; int ldt, koff = 0; const float* gk = nullptr;
            if (r < I_IN) { if ((r % 26) == 4 || (r % 26) == 5) continue;
                W = a.in[I_WIN] + (size_t)l * D * DIN; N = DIN; WT = (bf16*)(ws + WS_WIN) + (size_t)l * DIN * D; ldt = D; gk = a.in[I_NG] + l * D; }
            else if ((r -= I_IN) < I_GL) { W = a.in[I_WGLU] + (size_t)l * 512 * 512; N = 512; WT = (bf16*)(ws + WS_WGLU) + (size_t)l * 512 * 512; ldt = 512; }
            else if ((r -= I_GL) < 3 * I_BR) { const int kb3 = r / I_BR; r %= I_BR; W = a.in[I_WB] + (size_t)(l * 3 + kb3) * 512 * 1024; N = 1024; WT = (bf16*)(ws + WS_WBT) + (size_t)l * 1024 * 1536; ldt = 1536; koff = kb3 * 512; }
            else { r -= 3 * I_BR; W = a.in[I_WO] + (size_t)l * 1024 * 1024; N = 1024; WT = (bf16*)(ws + WS_WOT) + (size_t)l * 1024 * 1024; ldt = 1024; }
            const int nblk = N / 256, k0 = 64 * (r / nblk), n0 = 256 * (r % nblk);
            float* scr = (float*)lds;
#pragma unroll
            for (int i = 0; i < 8; ++i) { const int kk = i * 8 + (tid >> 6), c4 = (tid & 63) * 4;
                f32x4 v = *(const f32x4*)(W + (size_t)(k0 + kk) * N + n0 + c4); if (gk) v = v * gk[k0 + kk];
                scr[kk * 257 + c4] = v[0]; scr[kk * 257 + c4 + 1] = v[1]; scr[kk * 257 + c4 + 2] = v[2]; scr[kk * 257 + c4 + 3] = v[3]; }
            __syncthreads();
            const int c8 = tid & 7;
#pragma unroll
            for (int i = 0; i < 4; ++i) { const int n = (tid >> 3) + 64 * i; const float* sp = scr + (8 * c8) * 257 + n;
                v4u o; o.x = pk2(sp[0 * 257], sp[1 * 257]); o.y = pk2(sp[2 * 257], sp[3 * 257]); o.z = pk2(sp[4 * 257], sp[5 * 257]); o.w = pk2(sp[6 * 257], sp[7 * 257]);
                *(v4u*)(WT + (size_t)(n0 + n) * ldt + koff + k0 + 8 * c8) = o; }
            __syncthreads();
        }
    }
    __syncthreads();
    for (int task = bx; task < 128; task += G) {
        const int l = task >> 6, gi = (task >> 4) & 3, k0 = (task & 15) * 64;
        float* A = (float*)lds;
        float* Bp = A + 64 * 129;
        const float* win = a.in[I_WIN] + (size_t)l * D * DIN; const float* ng = a.in[I_NG] + l * D;
        for (int idx = tid; idx < 64 * 128; idx += 512) { const int kk = idx >> 7, cx = idx & 127; A[kk * 129 + cx] = win[(size_t)(k0 + kk) * DIN + 1024 + gi * 128 + cx] * ng[k0 + kk]; }
        for (int idx = tid; idx < 128 * 128; idx += 512) { const int dx = idx & 127; Bp[idx] = a.in[I_PW][(size_t)(l * 4 + gi) * 16384 + idx] * a.in[I_PS][l * 512 + gi * 128 + dx]; }
        __syncthreads();
        { const int dx = tid & 127, kq = tid >> 7; float o[16];
#pragma unroll
          for (int q = 0; q < 16; ++q) o[q] = 0.f;
          for (int cx = 0; cx < 128; ++cx) { const float bvv = Bp[cx * 128 + dx];
#pragma unroll
              for (int q = 0; q < 16; ++q) o[q] += A[(kq * 16 + q) * 129 + cx] * bvv; }
          v4u w0, w1; w0.x = pk2(o[0], o[1]); w0.y = pk2(o[2], o[3]); w0.z = pk2(o[4], o[5]); w0.w = pk2(o[6], o[7]); w1.x = pk2(o[8], o[9]); w1.y = pk2(o[10], o[11]); w1.z = pk2(o[12], o[13]); w1.w = pk2(o[14], o[15]);
          bf16* dst = (bf16*)(ws + WS_WIN) + (size_t)l * DIN * D + (size_t)(1024 + gi * 128 + dx) * D + k0 + kq * 16;
          *(v4u*)dst = w0; *(v4u*)(dst + 8) = w1; }
        __syncthreads();
    }
    {
        const size_t gt = (size_t)bx * 512 + tid, GT = (size_t)G * 512;
        bf16* pwt = (bf16*)(ws + WS_PWT); bf16* swt = (bf16*)(ws + WS_SWT);
        for (size_t idx = gt; idx < 2 * 2 * 65536; idx += GT) {
            const int k = idx & 255, n = (idx >> 8) & 255, q = (idx >> 16) & 1, l = (int)(idx >> 17);
            const int gl = n >> 7, d = n & 127, gl2 = k >> 7, c = k & 127;
            const float pv = (gl == gl2) ? a.in[I_PW][((size_t)(l * 4 + 2 * q + gl) * 128 + c) * 128 + d] : 0.f;
            pwt[idx] = (bf16)f2bf(pv);
            const int t = d, s = c;
            const float sv = (gl == gl2 && (s >> 6) <= (t >> 6)) ? a.in[I_SW][((size_t)(l * 4 + 2 * q + gl) * 128 + t) * 128 + s] : 0.f;
            swt[idx] = (bf16)f2bf(sv);
        }
    }
}

__device__ __forceinline__ void unpk8(const v4u q, float* v) { v[0] = pg8::bflo(q.x); v[1] = pg8::bfhi(q.x); v[2] = pg8::bflo(q.y); v[3] = pg8::bfhi(q.y); v[4] = pg8::bflo(q.z); v[5] = pg8::bfhi(q.z); v[6] = pg8::bflo(q.w); v[7] = pg8::bfhi(q.w); }
template <int W>
__device__ __forceinline__ void pool_item(const bf16* bv, const bf16* bg, bf16* ycat, int m0, int c0) {
    const int lpos0 = m0 & (SEQ - 1);
    v4u r[W + 7];
#pragma unroll
    for (int i = 0; i < W + 7; ++i) { const int off = i - (W - 1); r[i] = (lpos0 + off >= 0) ? *(const v4u*)(bv + (size_t)(m0 + off) * 512 + c0) : (v4u){0u, 0u, 0u, 0u}; }
    float s[8], v[8];
#pragma unroll
    for (int j = 0; j < 8; ++j) s[j] = 0.f;
#pragma unroll
    for (int i = 0; i < W - 1; ++i) { unpk8(r[i], v);
#pragma unroll
        for (int j = 0; j < 8; ++j) s[j] += v[j]; }
#pragma unroll
    for (int t = 0; t < 8; ++t) {
        float x0[8]; unpk8(r[W - 1 + t], x0);
#pragma unroll
        for (int j = 0; j < 8; ++j) s[j] += x0[j];
        const int n = (lpos0 + t + 1 < W) ? lpos0 + t + 1 : W; const float inv = 1.0f / (float)n; v4u o;
        float gq[8]; unpk8(*(const v4u*)(bg + (size_t)(m0 + t) * 512 + c0), gq);
        o.x = pk2((s[0] * inv - x0[0]) * gq[0], (s[1] * inv - x0[1]) * gq[1]); o.y = pk2((s[2] * inv - x0[2]) * gq[2], (s[3] * inv - x0[3]) * gq[3]);
        o.z = pk2((s[4] * inv - x0[4]) * gq[4], (s[5] * inv - x0[5]) * gq[5]); o.w = pk2((s[6] * inv - x0[6]) * gq[6], (s[7] * inv - x0[7]) * gq[7]);
        *(v4u*)(ycat + (size_t)(m0 + t) * 1536 + 512 + c0) = o;
        unpk8(r[t], v);
#pragma unroll
        for (int j = 0; j < 8; ++j) s[j] -= v[j];
    }
}
__device__ __forceinline__ void phase_pre(const Args& a, unsigned char* lds, int l, int vb, int VB) {
    const int tid = threadIdx.x, lane = tid & 63, wave = tid >> 6;
    unsigned char* ws = a.ws;
    bf16* ycat = (bf16*)(ws + WS_YCAT);
    {
        const bf16* cv = (const bf16*)(ws + WS_CV);
        const float* lng = a.in[I_LNG] + l * 512; const float* lnb = a.in[I_LNB] + l * 512;
        unsigned* T = (unsigned*)lds;
        for (int blk = vb; blk < 256; blk += VB) {
            float gg[8], bb[8];
#pragma unroll
            for (int j = 0; j < 8; ++j) { gg[j] = lng[lane * 8 + j]; bb[j] = lnb[lane * 8 + j]; }
            v4u wq[16];
#pragma unroll
            for (int i = 0; i < 16; ++i) wq[i] = *(const v4u*)(cv + ((size_t)blk * 128 + wave * 16 + i) * 512 + lane * 8);
#pragma unroll
            for (int i = 0; i < 16; ++i) { const int s = wave * 16 + i;
                float v[8]; unpk8(wq[i], v);
                float sm = 0.f;
#pragma unroll
                for (int j = 0; j < 8; ++j) sm += v[j];
                const float mu = wave_sum(sm) * (1.0f / 512.0f); float sq = 0.f;
#pragma unroll
                for (int j = 0; j < 8; ++j) { v[j] -= mu; sq += v[j] * v[j]; }
                const float rstd = rsqrtf(wave_sum(sq) * (1.0f / 512.0f) + 1e-5f);
#pragma unroll
                for (int j = 0; j < 4; ++j) T[s * 257 + lane * 4 + j] = pk2(v[2 * j] * rstd * gg[2 * j] + bb[2 * j], v[2 * j + 1] * rstd * gg[2 * j + 1] + bb[2 * j + 1]);
            }
            __syncthreads();
            const bf16* Tb = (const bf16*)T;
#pragma unroll 4
            for (int it = 0; it < 16; ++it) { const int idx = it * 512 + tid, sch = idx & 15, c = (idx >> 4) & 127, h = idx >> 11;
                unsigned o[4];
#pragma unroll
                for (int j = 0; j < 4; ++j) { const unsigned lo = Tb[(sch * 8 + 2 * j) * 514 + h * 128 + c], hi = Tb[(sch * 8 + 2 * j + 1) * 514 + h * 128 + c]; o[j] = lo | (hi << 16); }
                v4u ov; ov.x = o[0]; ov.y = o[1]; ov.z = o[2]; ov.w = o[3];
                *(v4u*)(ycat + ((size_t)blk * 128 + c) * 1536 + 1024 + h * 128 + sch * 8) = ov; }
            __syncthreads();
        }
    }
    {
        const bf16* bv = (const bf16*)(ws + WS_BV); const bf16* bg = (const bf16*)(ws + WS_BG);
        for (int task = vb * 8 + wave; task < 4096; task += VB * 8) {
            const int gi = task >> 10, tq = task & 1023, m0 = (tq * 4 + (lane >> 4)) * 8, c0 = gi * 128 + (lane & 15) * 8;
            if (gi == 0) pool_item<2>(bv, bg, ycat, m0, c0); else if (gi == 1) pool_item<4>(bv, bg, ycat, m0, c0); else if (gi == 2) pool_item<8>(bv, bg, ycat, m0, c0); else pool_item<16>(bv, bg, ycat, m0, c0);
        }
    }
}

__device__ __forceinline__ void prefix_rb(const Args& a, unsigned char* lds, int l, int rb) {
    int tid = threadIdx.x; asm volatile("" : "+v"(tid)); const int sg = tid >> 7, rl = tid & 127;
    float* tot = (float*)lds;
    {
        const int r = rb * 128 + rl, p = r & 63, b = (r >> 6) & 15, g = r >> 10, pair = g >> 1, gl = g & 1;
        const double dt0 = exp_small(0.25 * (double)a.in[I_LDT][l * 32 + g]); const double dt = (dt0 * dt0) * (dt0 * dt0);
        double are, aim; apow((double)a.in[I_LRE][(l * 32 + g) * 64 + p], (double)a.in[I_LIM][(l * 32 + g) * 64 + p], dt, 16, are, aim);
        const float ar = (float)are, ai = (float)aim;
        const float* loc = (const float*)(a.ws + WS_LOC) + ((size_t)pair * 2048 + b * 128 + sg * 32) * 256 + gl * 128 + p;
        bf16* av = (bf16*)(a.ws + WS_AVS) + ((size_t)pair * 2048 + b * 128 + sg * 32) * 768 + gl * 384 + 256 + p;
        float xr[32], xi[32];
#pragma unroll
        for (int k = 0; k < 32; ++k) { xr[k] = loc[(size_t)k * 256]; xi[k] = loc[(size_t)k * 256 + 64]; }
        float sr = 0.f, si = 0.f;
#pragma unroll
        for (int k = 0; k < 32; ++k) { const float tr = xr[k], ti = xi[k]; xr[k] = sr; xi[k] = si; const float nr = ar * sr - ai * si + tr, ni = ar * si + ai * sr + ti; sr = nr; si = ni; }
        tot[(sg * 128 + rl) * 2] = sr; tot[(sg * 128 + rl) * 2 + 1] = si;
        float Ar = ar, Ai = ai;
#pragma unroll
        for (int q = 0; q < 5; ++q) { const float nr = Ar * Ar - Ai * Ai, ni = 2.f * Ar * Ai; Ar = nr; Ai = ni; }
        __syncthreads();
        float cr = 0.f, ci = 0.f;
        for (int j = 0; j < sg; ++j) { const float tr = tot[(j * 128 + rl) * 2], ti = tot[(j * 128 + rl) * 2 + 1]; const float nr = Ar * cr - Ai * ci + tr, ni = Ar * ci + Ai * cr + ti; cr = nr; ci = ni; }
        float pr = 1.f, pi = 0.f;
#pragma unroll
        for (int k = 0; k < 32; ++k) { const float vr = xr[k] + pr * cr - pi * ci, vi = xi[k] + pr * ci + pi * cr;
            av[(size_t)k * 768] = (bf16)f2bf(vr); av[(size_t)k * 768 + 64] = (bf16)f2bf(vi);
            const float nr = pr * ar - pi * ai, ni = pr * ai + pi * ar; pr = nr; pi = ni; }
        __syncthreads();
    }
}

__device__ __forceinline__ void phase_final(const Args& a, int G) {
    const int lane = threadIdx.x & 63, wave = threadIdx.x >> 6, gw = blockIdx.x * 8 + wave, NGW = G * 8;
    const f32x4* gp = (const f32x4*)a.in[I_FG]; f32x4 gv[4];
#pragma unroll
    for (int j = 0; j < 4; ++j) gv[j] = gp[(lane * 8 + (j >> 1) * 512 + (j & 1) * 4) >> 2];
    const bf16* xbp = (const bf16*)(a.ws + WS_XB);
    for (int m = gw; m < M; m += NGW) {
        const v4u* xr = (const v4u*)(xbp + (size_t)m * D) + lane; float v[2][8]; float s = 0.f;
#pragma unroll
        for (int h = 0; h < 2; ++h) { unpk8(xr[64 * h], v[h]);
#pragma unroll
            for (int j = 0; j < 8; ++j) s += v[h][j] * v[h][j]; }
        const float rs = rsqrtf(wave_sum(s) * (1.0f / 1024.0f) + 1e-6f);
        f32x4* xo = (f32x4*)(a.out + (size_t)m * D);
#pragma unroll
        for (int h = 0; h < 2; ++h)
#pragma unroll
            for (int q = 0; q < 2; ++q) xo[(lane * 8 + h * 512 + q * 4) >> 2] = (f32x4){v[h][q * 4], v[h][q * 4 + 1], v[h][q * 4 + 2], v[h][q * 4 + 3]} * rs * gv[h * 2 + q];
    }
}

#define XB_TMO      128
#define XB_XCNT(j)  (256  + 64 * (j))
#define XB_XSUB(j)  (1280 + 64 * (j))
#define XB_XGEN(j)  (2304 + 64 * (j))
#define XB_TOP      3328
#define XB_TOPGEN   3392
#define XCD_BAR_WORDS 3456
#define XB_SPIN_CAP (1u << 18)
__device__ __forceinline__ unsigned xb_ld(unsigned* p)              { return __hip_atomic_load(p, __ATOMIC_RELAXED, __HIP_MEMORY_SCOPE_AGENT); }
__device__ __forceinline__ unsigned xb_add(unsigned* p, unsigned v) { return __hip_atomic_fetch_add(p, v, __ATOMIC_RELAXED, __HIP_MEMORY_SCOPE_AGENT); }
__device__ __forceinline__ unsigned xb_xcc_id() { return (unsigned)__builtin_amdgcn_s_getreg((3 << 11) | 20) & 0xFu; }
#define XB_SPIN(cond, bar) do { unsigned _sp = 0; while (cond) { __builtin_amdgcn_s_sleep(1); \
    if ((++_sp & 255u) == 0u) { if (xb_ld(&(bar)[XB_TMO])) break; if (_sp > XB_SPIN_CAP) { atomicAdd(&(bar)[XB_TMO], 1u); break; } } } } while (0)
struct XcdBarrier { unsigned* bar; unsigned x; volatile LAS unsigned* st; };
__device__ __forceinline__ void xcd_barrier_complete(unsigned* bar, unsigned x, unsigned& nloc, unsigned& nx) {
    const unsigned G = gridDim.x * gridDim.y * gridDim.z;
    unsigned sum, cnt, mine, sp = 0u;
    for (;;) {
        sum = 0u; cnt = 0u; mine = 0u;
#pragma unroll
        for (unsigned j = 0; j < 16; ++j) { const unsigned c = xb_ld(&bar[XB_XCNT(j)]); sum += c; cnt += (c > 0u) ? 1u : 0u; mine = (j == x) ? c : mine; }
        if (sum == G) break;
        __builtin_amdgcn_s_sleep(1);
        if ((++sp & 255u) == 0u) { if (xb_ld(&bar[XB_TMO])) break; if (sp > XB_SPIN_CAP) { atomicAdd(&bar[XB_TMO], 1u); break; } }
    }
    nloc = mine > 0u ? mine : 1u; nx = cnt > 0u ? cnt : 1u;
}
__device__ __forceinline__ void xcd_barrier(const XcdBarrier& b) {
    asm volatile("s_waitcnt vmcnt(0)" ::: "memory");
    __syncthreads();
    if (threadIdx.x == 0) {
        unsigned* bar = b.bar;
        __builtin_amdgcn_s_waitcnt(0);
        unsigned nloc = b.st[0], nx = b.st[1];
        if (nloc == 0u) { xcd_barrier_complete(bar, b.x, nloc, nx); b.st[0] = nloc; b.st[1] = nx; }
        const unsigned old = xb_add(&bar[XB_XSUB(b.x)], 1u);
        const unsigned gen = old / nloc;
        if (old + 1u == (gen + 1u) * nloc) {
            __builtin_amdgcn_fence(__ATOMIC_RELEASE, "agent");
            asm volatile("s_waitcnt vmcnt(0)" ::: "memory");
            const unsigned og = xb_add(&bar[XB_TOP], 1u);
            const unsigned tg = og / nx;
            if (og + 1u == (tg + 1u) * nx) xb_add(&bar[XB_TOPGEN], 1u);
            else XB_SPIN(xb_ld(&bar[XB_TOPGEN]) == tg, bar);
            __builtin_amdgcn_fence(__ATOMIC_ACQUIRE, "agent");
            xb_add(&bar[XB_XGEN(b.x)], 1u);
            asm volatile("s_waitcnt vmcnt(0)" ::: "memory");
        } else {
            XB_SPIN(xb_ld(&bar[XB_XGEN(b.x)]) == gen, bar);
            __builtin_amdgcn_fence(__ATOMIC_ACQUIRE, "agent");
            asm volatile("s_waitcnt vmcnt(0)" ::: "memory");
        }
    }
    __syncthreads();
}

struct Ctx { const Args& a; unsigned char* lds; PG8_LAS unsigned char* ldsl; int G, bx; };
#define CTX_PTRS(l) unsigned char* ws = c.a.ws; asm volatile("" : "+s"(ws)); const Args& a = c.a; const int G = c.G, bx = c.bx; PG8_LAS unsigned char* ldsl = c.ldsl; \
    bf16* xb = (bf16*)(ws + WS_XB); bf16* ycat = (bf16*)(ws + WS_YCAT); bf16* avs = (bf16*)(ws + WS_AVS); bf16* gt = (bf16*)(ws + WS_GT); \
    const float* ssq = (const float*)(ws + ((l) == 0 ? WS_SSQ0 : WS_SSQ1)); const bf16* win = (const bf16*)(ws + WS_WIN) + (size_t)(l) * DIN * D; pg8::Order S; \
    (void)xb; (void)ycat; (void)avs; (void)gt; (void)ssq; (void)win; (void)a; (void)G; (void)bx; (void)ldsl;
__device__ __forceinline__ void run_pa(const Ctx& c, int l) { CTX_PTRS(l)
    pg8::Gemm g{xb, win, D, D, D, 0, 0, 0, 0, 0}; S.init(128, 14, 1, G, bx);
    pg8::EpiIn E{ssq, avs, (bf16*)(ws + WS_AG), (bf16*)(ws + WS_BV), (bf16*)(ws + WS_BG), (bf16*)(ws + WS_CU), (bf16*)(ws + WS_CV), (bf16*)(ws + WS_CG), gt, 0};
    pg8::gemm_phase<pg8::EpiIn>(ldsl, g, S, E); }
__device__ __forceinline__ void block_publish() { asm volatile("s_waitcnt vmcnt(0)" ::: "memory"); __syncthreads(); __builtin_amdgcn_fence(__ATOMIC_ACQUIRE, "agent"); asm volatile("s_waitcnt vmcnt(0)" ::: "memory"); }
__device__ __forceinline__ void pb_state_task(const Ctx& c, int l, int task) { CTX_PTRS(l)
    const int pair = task >> 3, pm = task & 7;
    { pg8::Gemm g{avs, (const bf16*)(ws + WS_WST) + (size_t)l * 16 * 256 * 768, 768, 768, 768, 2048L * 768, 256L * 768, 0, 0, 0}; S.init(8, 1, 16, 1 << 20, pair * 8 + pm, 1);
      pg8::EpiState E{(float*)(ws + WS_LOC)};
      pg8::gemm_phase<pg8::EpiState>(ldsl, g, S, E); }
    block_publish();
    prefix_rb(a, c.lds, l, (2 * pair) * 8 + pm); prefix_rb(a, c.lds, l, (2 * pair + 1) * 8 + pm);
}
__device__ __forceinline__ void run_pb(const Ctx& c, int l) {
    const int G = c.G, bx = c.bx, half = G / 2;
    if (G >= 2 && bx >= half) phase_pre(c.a, c.lds, l, bx - half, G - half);
    else {
        if (G < 2) phase_pre(c.a, c.lds, l, 0, 1);
        const int step = G >= 2 ? half : 1;
#pragma unroll 1
        for (int task = bx; task < 128; task += step) pb_state_task(c, l, task);
    } }
__device__ __forceinline__ void run_pc(const Ctx& c, int l) { CTX_PTRS(l)
    { pg8::Gemm g{ycat + 1024, (const bf16*)(ws + WS_SWT) + (size_t)l * 2 * 65536, 1536, 256, 256, 256, 65536, 0, 0, 0}; S.init(128, 1, 2, G, bx);
      pg8::EpiSgu E{(const bf16*)(ws + WS_CU), (const bf16*)(ws + WS_CG), a.in[I_SB] + l * 512, ycat};
      pg8::gemm_phase<pg8::EpiSgu>(ldsl, g, S, E); } }
__device__ __forceinline__ void run_pd(const Ctx& c, int l) { CTX_PTRS(l)
    pg8::Gemm g{avs, (const bf16*)(ws + WS_TP) + (size_t)l * 32 * 256 * 384, 768, 384, 384, 2048L * 768, 256L * 384, 1, 1, 384}; S.init(8, 1, 32, G, bx);
    pg8::EpiToep E{avs, a.in[I_SD] + l * 512, (bf16*)(ws + WS_YG)};
    pg8::gemm_phase<pg8::EpiToep>(ldsl, g, S, E); }
__device__ __forceinline__ void run_pe(const Ctx& c, int l) { CTX_PTRS(l)
    const bool split = (G == 256);
    if (!split || bx < 128) { pg8::Gemm g{(const bf16*)(ws + WS_YG), (const bf16*)(ws + WS_WGLU) + (size_t)l * 512 * 512, 512, 512, 512, 0, 0, 0, 0, 0};
      if (split) S.init(128, 2, 1, 128, bx, 2); else S.init(128, 2, 1, G, bx);
      pg8::EpiGlu E{(const bf16*)(ws + WS_YG), (const bf16*)(ws + WS_AG), a.in[I_BGLU] + l * 512, ycat};
      pg8::gemm_phase<pg8::EpiGlu>(ldsl, g, S, E); }
    { pg8::Gemm g{xb, win + (size_t)3584 * D, D, D, D, 0, 0, 0, 0, 0}; S.init(128, 12, 1, G, bx); S.uneven = split ? 1 : 0;
      pg8::EpiIn E{ssq, avs, nullptr, nullptr, nullptr, nullptr, nullptr, nullptr, gt, 1};
      pg8::gemm_phase<pg8::EpiIn>(ldsl, g, S, E); } }
__device__ __forceinline__ void run_pf(const Ctx& c, int l) { CTX_PTRS(l)
    pg8::Gemm g{ycat, (const bf16*)(ws + WS_WBT) + (size_t)l * 1024 * 1536, 1536, 1536, 1536, 0, 0, 0, 0, 0}; S.init(128, 4, 1, G, bx);
    pg8::EpiBranch E{gt, (bf16*)(ws + WS_MG)};
    pg8::gemm_phase<pg8::EpiBranch>(ldsl, g, S, E); }
__device__ __forceinline__ void run_pg(const Ctx& c, int l, bool dry = false) { CTX_PTRS(l)
    pg8::Gemm g{(const bf16*)(ws + WS_MG), (const bf16*)(ws + WS_WOT) + (size_t)l * 1024 * 1024, 1024, 1024, 1024, 0, 0, 0, 0, 0}; S.init(128, 4, 1, G, bx);
    pg8::EpiOut E{xb, (l == 0 && !dry) ? (float*)(ws + WS_SSQ1) : nullptr};
    pg8::gemm_phase<pg8::EpiOut>(ldsl, g, S, E); }

template <int L>
__device__ __forceinline__ void layer_phases(const Ctx& c, int lo, int hi, bool coop, const XcdBarrier& bar) {
#define IN(k) (lo <= (k) && (k) < hi)
#define SEAM(k) do { if (coop && IN(k) && IN((k) + 1)) xcd_barrier(bar); } while (0)
    constexpr int P = 1 + 7 * L;
    if (IN(P + 0)) { run_pa(c, L); if (REPM & 1) run_pa(c, L); }
    SEAM(P + 0);
    if (IN(P + 1)) { run_pb(c, L); if (REPM & 2) run_pb(c, L); }
    SEAM(P + 1);
    if (IN(P + 2)) { run_pc(c, L); run_pd(c, L); if (REPM & 8) run_pd(c, L); }
    SEAM(P + 3);
    if (IN(P + 4)) { run_pe(c, L); if (REPM & 16) run_pe(c, L); }
    SEAM(P + 4);
    if (IN(P + 5)) { run_pf(c, L); if (REPM & 32) run_pf(c, L); }
    SEAM(P + 5);
    if (IN(P + 6)) { if ((REPM & 512) && L == 0) run_pg(c, L, true); run_pg(c, L); }
    SEAM(P + 6);
}

__global__ void __launch_bounds__(512, 2) trunk_fwd(Args a) {
    extern __shared__ __attribute__((aligned(16))) unsigned char lds[];
    const int lo = a.ph_lo, hi = a.ph_hi; const bool coop = a.coop != 0;
    const Ctx c{a, lds, (PG8_LAS unsigned char*)lds, (int)gridDim.x, (int)blockIdx.x};
    volatile LAS unsigned* st = (volatile LAS unsigned*)((PG8_LAS unsigned char*)lds + LDS_BYTES - 16);
    if (threadIdx.x == 0) { st[0] = 0u; st[1] = 0u; }
    __syncthreads();
    if (IN(0)) {
        if (blockIdx.x == 0) { unsigned* bw = (unsigned*)(a.ws + WS_BAR); for (int i = threadIdx.x; i < XCD_BAR_WORDS; i += 512) bw[i] = 0u; }
        if (blockIdx.x & 1) { setup_x(a, c.G); phase_setup(a, lds, c.G); } else { phase_setup(a, lds, c.G); setup_x(a, c.G); }
        if (REPM & 64) { phase_setup(a, lds, c.G); setup_x(a, c.G); } }
    XcdBarrier bar; bar.bar = (unsigned*)(a.ws + WS_BAR); bar.x = xb_xcc_id(); bar.st = st;
    if (coop && IN(0) && IN(1)) {
        cg::this_grid().sync();
        if (threadIdx.x == 0) (void)xb_add(&bar.bar[XB_XCNT(bar.x)], 1u);
    }
    if (REPM & 0x100) { if (coop) for (int i = 0; i < 16; ++i) xcd_barrier(bar); }
    layer_phases<0>(c, lo, hi, coop, bar);
    layer_phases<1>(c, lo, hi, coop, bar);
    if (IN(NPH - 1)) phase_final(a, c.G);
#undef IN
#undef SEAM
}

extern "C" void kernel_launch(void* const* d_in, const int* in_sizes, int n_in, void* d_out, int out_size, void* d_ws, size_t ws_size, hipStream_t stream) {
    static int grid = 0;
    if (grid == 0) {
        if (n_in != 22 || out_size != M * D || ws_size < WS_END) { fprintf(stderr, "kernel_launch: unexpected shapes (n_in %d out %d ws %zu)\n", n_in, out_size, ws_size); grid = -1; return; }
        int dev = 0, cus = 0, per_cu = 0;
        hipGetDevice(&dev); hipDeviceGetAttribute(&cus, hipDeviceAttributeMultiprocessorCount, dev);
        if (hipFuncSetAttribute((const void*)trunk_fwd, hipFuncAttributeMaxDynamicSharedMemorySize, LDS_BYTES) != hipSuccess) { fprintf(stderr, "kernel_launch: hipFuncSetAttribute failed\n"); grid = -1; return; }
        if (hipOccupancyMaxActiveBlocksPerMultiprocessor(&per_cu, (const void*)trunk_fwd, 512, LDS_BYTES) != hipSuccess || per_cu < 1) { fprintf(stderr, "kernel_launch: occupancy query says %d\n", per_cu); per_cu = 1; }
        (void)hipGetLastError();
        grid = cus * 1;
        if (grid > cus * per_cu) grid = cus * per_cu;
    }
    if (grid < 0) return;
    Args a{};
    for (int i = 0; i < 22; ++i) a.in[i] = (const float*)d_in[i];
    a.out = (float*)d_out; a.ws = (unsigned char*)d_ws; a.pad = 0;
#if MK_COOP
    a.ph_lo = 0; a.ph_hi = NPH; a.coop = 1;
    void* args[] = {&a};
    hipError_t e = hipLaunchCooperativeKernel((const void*)trunk_fwd, dim3(grid), dim3(512), args, LDS_BYTES, stream);
    if (e != hipSuccess) fprintf(stderr, "cooperative launch failed: %s (grid %d)\n", hipGetErrorString(e), grid);
#else
    for (int ph = 0; ph < NPH; ++ph) { a.ph_lo = ph; a.ph_hi = ph + 1; a.coop = 0; hipLaunchKernelGGL(trunk_fwd, dim3(grid), dim3(512), LDS_BYTES, stream, a); }
#endif
}
```
